# Optimizing an MI355X kernel written in HIP

```python
import math
import jax, jax.numpy as jnp
from jax import lax
import numpy as np

D_MODEL = 2048
BATCH = 4
SEQ = 2048
DEPTH = 2
DEC_BATCH = 128
DEC_SEQ = 8
PAST_LEN = 16384
PAGE_SIZE = 128

RWKV_HEADS = 12
RWKV_HEAD_DIM = 64
RWKV_WIDTH = RWKV_HEADS * RWKV_HEAD_DIM
RWKV_DECAY_RANK = 64
RWKV_AAA_RANK = 64
RWKV_GATE_RANK = 128
RWKV_COLS = 3 * RWKV_WIDTH + RWKV_DECAY_RANK + RWKV_AAA_RANK + RWKV_GATE_RANK
RWKV_SPLITS = (RWKV_WIDTH, 2 * RWKV_WIDTH, 3 * RWKV_WIDTH,
               3 * RWKV_WIDTH + RWKV_DECAY_RANK,
               3 * RWKV_WIDTH + RWKV_DECAY_RANK + RWKV_AAA_RANK)
RWKV_LN_EPS = 64e-5
HGRN_HEADS = 6
HGRN_EXPAND = 128
HGRN_HEAD_DIM = 128
HGRN_WIDTH = HGRN_HEADS * HGRN_HEAD_DIM
HGRN_COLS = 4 * HGRN_WIDTH
HGRN_CHUNK = 16
LRU_BLOCKS = 8
LRU_BLOCK_DIM = 64
LRU_WIDTH = LRU_BLOCKS * LRU_BLOCK_DIM
LRU_CONV = 4
LRU_C = 8.0
LRU_COLS = 2 * LRU_WIDTH
MIX_WIDTH = RWKV_WIDTH + HGRN_WIDTH + LRU_WIDTH
IN_COLS = RWKV_COLS + HGRN_COLS + LRU_COLS
D_FF = 5632
FFN_CONV = 3
NORM_EPS = 1e-6

kernel_name = 'hybrid_rwkv7_hgrn2_rglru_convffn_step'


def rms_norm(x, w):
    xf = x.astype(jnp.float32)
    y = xf * lax.rsqrt(jnp.mean(xf * xf, axis=-1, keepdims=True) + NORM_EPS)
    return (y * w.astype(jnp.float32)).astype(x.dtype)


def causal_dwconv(x, buf, w, b):
    K = w.shape[0]
    T = x.shape[1]
    xp = jnp.concatenate([buf.astype(x.dtype), x], axis=1)
    y = b
    for j in range(K):
        y = y + w[j] * xp[:, j:j + T]
    return y, xp[:, T:]


def rwkv7_scan(S0, r, w, k, v, a, b):
    def step(S, inp):
        r_t, w_t, k_t, v_t, a_t, b_t = inp
        sa = jnp.einsum('bhvk,bhk->bhv', S, a_t)
        S = (S * w_t[:, :, None, :] + sa[..., None] * b_t[:, :, None, :]
             + v_t[..., None] * k_t[:, :, None, :])
        return S, jnp.einsum('bhvk,bhk->bhv', S, r_t)
    xs = tuple(jnp.moveaxis(t, 1, 0) for t in (r, w, k, v, a, b))
    S, ys = lax.scan(step, S0, xs)
    return jnp.moveaxis(ys, 0, 1), S


def rwkv7_mix(p, shift_prev, S0, lp):
    B, T, _ = p.shape
    H, N = RWKV_HEADS, RWKV_HEAD_DIM
    f32 = jnp.float32
    prev = jnp.concatenate([shift_prev[:, None].astype(p.dtype), p[:, :-1]], axis=1)
    xs = p + (prev - p) * lp['rwkv_mu']
    r, k, v, xw, xa, xg = jnp.split(xs, RWKV_SPLITS, axis=-1)
    w_log = -jax.nn.softplus(-(lp['rwkv_w0'] + jnp.tanh(xw) @ lp['rwkv_w2']).astype(f32)) - 0.5
    decay = jnp.exp(-jnp.exp(w_log))
    a = jax.nn.sigmoid((lp['rwkv_a0'] + xa @ lp['rwkv_a2']).astype(f32))
    g = jax.nn.sigmoid(xg) @ lp['rwkv_g2']
    kf = k.astype(f32)
    kk = (kf * lp['rwkv_k_k']).reshape(B, T, H, N)
    kk = kk / jnp.maximum(jnp.sqrt(jnp.sum(kk * kk, axis=-1, keepdims=True)), 1e-12)
    kf = kf * (1.0 + (a - 1.0) * lp['rwkv_k_a'])
    hd = lambda t: t.astype(f32).reshape(B, T, H, N)
    r_h, k_h, v_h, a_h, w_h = hd(r), hd(kf), hd(v), hd(a), hd(decay)
    y, S = rwkv7_scan(S0.astype(f32), r_h, w_h, k_h, v_h, -kk, kk * a_h)
    mean = jnp.mean(y, axis=-1, keepdims=True)
    var = jnp.mean(jnp.square(y - mean), axis=-1, keepdims=True)
    y = (y - mean) * lax.rsqrt(var + RWKV_LN_EPS)
    y = y.reshape(B, T, RWKV_WIDTH) * lp['rwkv_ln_w'] + lp['rwkv_ln_b']
    bonus = jnp.sum(r_h * k_h * lp['rwkv_r_k'], axis=-1, keepdims=True) * v_h
    y = (y + bonus.reshape(B, T, RWKV_WIDTH)) * g
    return y.astype(p.dtype), S.astype(p.dtype), p[:, -1]


def hgrn2_chunked(S0, q, k, v, log_f):
    B, T, H, DK = q.shape
    DV = v.shape[-1]
    C = math.gcd(T, HGRN_CHUNK)
    N = T // C
    to_chunks = lambda t: jnp.moveaxis(t.reshape(B, N, C, H, t.shape[-1]), 1, 0)
    causal = jnp.tril(jnp.ones((C, C), dtype=bool))[None, :, :, None, None]

    def step(S, inp):
        q_c, k_c, v_c, lf_c = inp
        b = jnp.cumsum(lf_c, axis=1)
        o_inter = jnp.einsum('bthk,bhkv->bthv', q_c * jnp.exp(b), S)
        dec = jnp.exp(jnp.where(causal, b[:, :, None] - b[:, None, :], -jnp.inf))
        A = jnp.einsum('bthk,btshk,bshk->btsh', q_c, dec, k_c)
        o = o_inter + jnp.einsum('btsh,bshv->bthv', A, v_c)
        b_last = b[:, -1]
        S = (jnp.exp(b_last)[..., None] * S
             + jnp.einsum('bshk,bshv->bhkv', k_c * jnp.exp(b_last[:, None] - b), v_c))
        return S, o

    S, o = lax.scan(step, S0, (to_chunks(q), to_chunks(k), to_chunks(v), to_chunks(log_f)))
    return jnp.moveaxis(o, 0, 1).reshape(B, T, H, DV), S


def hgrn2_mix(p, S0, lp):
    B, T, _ = p.shape
    f32 = jnp.float32
    q, f, i, g = jnp.split(p, 4, axis=-1)
    q = jax.nn.silu(q.astype(f32))
    lb = lp['hgrn_lb']
    fg = lb + (1.0 - lb) * jax.nn.sigmoid(f.astype(f32))
    log_f = jnp.log(fg)
    k = 1.0 - fg
    hd = lambda t, d: t.astype(f32).reshape(B, T, HGRN_HEADS, d)
    o, S = hgrn2_chunked(S0.astype(f32), hd(q, HGRN_EXPAND), hd(k, HGRN_EXPAND),
                         hd(i, HGRN_HEAD_DIM), hd(log_f, HGRN_EXPAND))
    o = rms_norm(o, lp['hgrn_norm_w'].reshape(HGRN_HEADS, HGRN_HEAD_DIM)).reshape(B, T, HGRN_WIDTH)
    o = o * jax.nn.silu(g.astype(f32))
    return o.astype(p.dtype), S.astype(p.dtype)


def rglru_mix(p, conv_buf, h0, lp):
    B, T, _ = p.shape
    f32 = jnp.float32
    xb, gate = jnp.split(p, 2, axis=-1)
    xc, new_buf = causal_dwconv(xb, conv_buf, lp['rglru_conv_w'], lp['rglru_conv_b'])
    xh = xc.reshape(B, T, LRU_BLOCKS, LRU_BLOCK_DIM)
    gr = jnp.einsum('bthi,hij->bthj', xh, lp['rglru_wa']).reshape(B, T, LRU_WIDTH) + lp['rglru_ba']
    gi = jnp.einsum('bthi,hij->bthj', xh, lp['rglru_wx']).reshape(B, T, LRU_WIDTH) + lp['rglru_bx']
    r = jax.nn.sigmoid(gr.astype(f32))
    i = jax.nn.sigmoid(gi.astype(f32))
    log_a = -LRU_C * r * jax.nn.softplus(-lp['rglru_lambda'].astype(f32))
    a = jnp.exp(log_a)
    u = jnp.sqrt(-jnp.expm1(2.0 * log_a)) * (i * xc.astype(f32))

    def combine(lhs, rhs):
        a1, b1 = lhs
        a2, b2 = rhs
        return a1 * a2, a2 * b1 + b2

    a_cum, h = lax.associative_scan(combine, (a, u), axis=1)
    h = h + a_cum * h0.astype(f32)[:, None]
    y = h * jax.nn.gelu(gate.astype(f32))
    return y.astype(p.dtype), new_buf, h[:, -1].astype(p.dtype)


def trunk_layer(x, st, lp):
    S_rw, shift_rw, S_hg, h_lru, buf_lru, buf_ffn = st
    hn = rms_norm(x, lp['norm_mix'])
    proj = hn @ lp['w_in']
    p_rw, p_hg, p_lru = jnp.split(proj, (RWKV_COLS, RWKV_COLS + HGRN_COLS), axis=-1)
    y_rw, S_rw, shift_rw = rwkv7_mix(p_rw, shift_rw, S_rw, lp)
    y_hg, S_hg = hgrn2_mix(p_hg, S_hg, lp)
    y_lru, buf_lru, h_lru = rglru_mix(p_lru, buf_lru, h_lru, lp)
    x = x + jnp.concatenate([y_rw, y_hg, y_lru], axis=-1) @ lp['w_out']
    hn = rms_norm(x, lp['norm_ffn'])
    gte, val = jnp.split(hn @ lp['ffn_w_up'], 2, axis=-1)
    gc, buf_ffn = causal_dwconv(gte, buf_ffn, lp['ffn_conv_w'], lp['ffn_conv_b'])
    x = x + (jax.nn.silu(gc) * val) @ lp['ffn_w_down']
    return x, (S_rw, shift_rw, S_hg, h_lru, buf_lru, buf_ffn)


def zero_states(batch, dtype):
    return (jnp.zeros((batch, RWKV_HEADS, RWKV_HEAD_DIM, RWKV_HEAD_DIM), dtype),
            jnp.zeros((batch, RWKV_COLS), dtype),
            jnp.zeros((batch, HGRN_HEADS, HGRN_EXPAND, HGRN_HEAD_DIM), dtype),
            jnp.zeros((batch, LRU_WIDTH), dtype),
            jnp.zeros((batch, LRU_CONV - 1, LRU_WIDTH), dtype),
            jnp.zeros((batch, FFN_CONV - 1, D_FF), dtype))


def setup_inputs(seed: int = 0) -> dict:
    key = jax.random.key(seed)
    ks = iter(jax.random.split(key, 48))
    f32 = jnp.float32
    nrm = lambda shape, scale: scale * jax.random.normal(next(ks), shape, f32)
    uni = lambda shape, lo, hi: jax.random.uniform(next(ks), shape, f32, minval=lo, maxval=hi)
    lam_a = uni((DEPTH, LRU_WIDTH), 0.9, 0.999)
    lam_s = lam_a ** (1.0 / LRU_C)
    return {
        'x_prompt': nrm((BATCH, SEQ, D_MODEL), 1.0),
        'x_sample': nrm((DEC_BATCH, DEC_SEQ, D_MODEL), 1.0),
        'state_rwkv': nrm((DEPTH, DEC_BATCH, RWKV_HEADS, RWKV_HEAD_DIM, RWKV_HEAD_DIM), 0.5),
        'state_rwkv_shift': nrm((DEPTH, DEC_BATCH, RWKV_COLS), 1.0),
        'state_hgrn': nrm((DEPTH, DEC_BATCH, HGRN_HEADS, HGRN_EXPAND, HGRN_HEAD_DIM), 0.5),
        'state_rglru': nrm((DEPTH, DEC_BATCH, LRU_WIDTH), 0.5),
        'cache_rglru_conv': nrm((DEPTH, DEC_BATCH, LRU_CONV - 1, LRU_WIDTH), 1.0),
        'cache_ffn_conv': nrm((DEPTH, DEC_BATCH, FFN_CONV - 1, D_FF), 1.0),
        'norm_mix': 1.0 + nrm((DEPTH, D_MODEL), 0.02),
        'w_in': nrm((DEPTH, D_MODEL, IN_COLS), D_MODEL ** -0.5),
        'rwkv_mu': uni((DEPTH, RWKV_COLS), 0.0, 1.0),
        'rwkv_w0': uni((DEPTH, RWKV_WIDTH), -6.0, 0.0),
        'rwkv_w2': nrm((DEPTH, RWKV_DECAY_RANK, RWKV_WIDTH), 0.5 * RWKV_DECAY_RANK ** -0.5),
        'rwkv_a0': nrm((DEPTH, RWKV_WIDTH), 0.1),
        'rwkv_a2': nrm((DEPTH, RWKV_AAA_RANK, RWKV_WIDTH), RWKV_AAA_RANK ** -0.5),
        'rwkv_g2': nrm((DEPTH, RWKV_GATE_RANK, RWKV_WIDTH), RWKV_GATE_RANK ** -0.5),
        'rwkv_k_k': 0.85 + nrm((DEPTH, RWKV_WIDTH), 0.05),
        'rwkv_k_a': 1.0 + nrm((DEPTH, RWKV_WIDTH), 0.05),
        'rwkv_r_k': nrm((DEPTH, RWKV_HEADS, RWKV_HEAD_DIM), 0.1),
        'rwkv_ln_w': 1.0 + nrm((DEPTH, RWKV_WIDTH), 0.02),
        'rwkv_ln_b': nrm((DEPTH, RWKV_WIDTH), 0.02),
        'hgrn_lb_logits': nrm((DEPTH, HGRN_WIDTH), 0.5),
        'hgrn_norm_w': 1.0 + nrm((DEPTH, HGRN_WIDTH), 0.02),
        'rglru_conv_w': nrm((DEPTH, LRU_CONV, LRU_WIDTH), LRU_CONV ** -0.5),
        'rglru_conv_b': nrm((DEPTH, LRU_WIDTH), 0.02),
        'rglru_wa': nrm((DEPTH, LRU_BLOCKS, LRU_BLOCK_DIM, LRU_BLOCK_DIM), LRU_BLOCK_DIM ** -0.5),
        'rglru_ba': nrm((DEPTH, LRU_WIDTH), 0.02),
        'rglru_wx': nrm((DEPTH, LRU_BLOCKS, LRU_BLOCK_DIM, LRU_BLOCK_DIM), LRU_BLOCK_DIM ** -0.5),
        'rglru_bx': nrm((DEPTH, LRU_WIDTH), 0.02),
        'rglru_lambda': jnp.log(lam_s) - jnp.log1p(-lam_s),
        'w_out': nrm((DEPTH, MIX_WIDTH, D_MODEL), MIX_WIDTH ** -0.5),
        'norm_ffn': 1.0 + nrm((DEPTH, D_MODEL), 0.02),
        'ffn_w_up': nrm((DEPTH, D_MODEL, 2 * D_FF), D_MODEL ** -0.5),
        'ffn_conv_w': nrm((DEPTH, FFN_CONV, D_FF), FFN_CONV ** -0.5),
        'ffn_conv_b': nrm((DEPTH, D_FF), 0.02),
        'ffn_w_down': nrm((DEPTH, D_FF, D_MODEL), D_FF ** -0.5),
        'norm_final': 1.0 + nrm((D_MODEL,), 0.02),
    }


def reference(x_prompt, x_sample, state_rwkv, state_rwkv_shift, state_hgrn, state_rglru,
              cache_rglru_conv, cache_ffn_conv, norm_mix, w_in, rwkv_mu, rwkv_w0, rwkv_w2,
              rwkv_a0, rwkv_a2, rwkv_g2, rwkv_k_k, rwkv_k_a, rwkv_r_k, rwkv_ln_w, rwkv_ln_b,
              hgrn_lb_logits, hgrn_norm_w, rglru_conv_w, rglru_conv_b, rglru_wa, rglru_ba,
              rglru_wx, rglru_bx, rglru_lambda, w_out, norm_ffn, ffn_w_up, ffn_conv_w,
              ffn_conv_b, ffn_w_down, norm_final):
    gam = jax.nn.softmax(hgrn_lb_logits.astype(jnp.float32), axis=0)
    lower_bounds = jnp.cumsum(gam, axis=0) - gam[0]
    x_p, x_s = x_prompt, x_sample
    new_p, new_s = [], []
    for l in range(DEPTH):
        lp = {
            'norm_mix': norm_mix[l], 'w_in': w_in[l], 'rwkv_mu': rwkv_mu[l],
            'rwkv_w0': rwkv_w0[l], 'rwkv_w2': rwkv_w2[l], 'rwkv_a0': rwkv_a0[l],
            'rwkv_a2': rwkv_a2[l], 'rwkv_g2': rwkv_g2[l], 'rwkv_k_k': rwkv_k_k[l],
            'rwkv_k_a': rwkv_k_a[l], 'rwkv_r_k': rwkv_r_k[l], 'rwkv_ln_w': rwkv_ln_w[l],
            'rwkv_ln_b': rwkv_ln_b[l], 'hgrn_lb': lower_bounds[l], 'hgrn_norm_w': hgrn_norm_w[l],
            'rglru_conv_w': rglru_conv_w[l], 'rglru_conv_b': rglru_conv_b[l],
            'rglru_wa': rglru_wa[l], 'rglru_ba': rglru_ba[l], 'rglru_wx': rglru_wx[l],
            'rglru_bx': rglru_bx[l], 'rglru_lambda': rglru_lambda[l], 'w_out': w_out[l],
            'norm_ffn': norm_ffn[l], 'ffn_w_up': ffn_w_up[l], 'ffn_conv_w': ffn_conv_w[l],
            'ffn_conv_b': ffn_conv_b[l], 'ffn_w_down': ffn_w_down[l],
        }
        x_p, sp = trunk_layer(x_p, zero_states(x_p.shape[0], x_p.dtype), lp)
        x_s, ss = trunk_layer(x_s, (state_rwkv[l], state_rwkv_shift[l], state_hgrn[l],
                                    state_rglru[l], cache_rglru_conv[l], cache_ffn_conv[l]), lp)
        new_p.append(sp)
        new_s.append(ss)
    y_prompt = rms_norm(x_p, norm_final)
    y_sample = rms_norm(x_s, norm_final)
    p_rwkv, p_rwkv_shift, p_hgrn, p_rglru, p_rglru_conv, p_ffn_conv = [
        jnp.stack(s, axis=0) for s in zip(*new_p)]
    s_rwkv, s_rwkv_shift, s_hgrn, s_rglru, s_rglru_conv, s_ffn_conv = [
        jnp.stack(s, axis=0) for s in zip(*new_s)]
    return (y_prompt, y_sample,
            p_rwkv, p_rwkv_shift, p_hgrn, p_rglru, p_rglru_conv, p_ffn_conv,
            s_rwkv, s_rwkv_shift, s_hgrn, s_rglru, s_rglru_conv, s_ffn_conv)
```

```cpp
#include <hip/hip_runtime.h>
#include <hip/hip_cooperative_groups.h>
#include <cstdio>
#include <cstdint>
namespace cg = cooperative_groups;
namespace pg8 {
#define PG8_LAS __attribute__((address_space(3)))
typedef unsigned short bf16_t;
typedef short bf16x8 __attribute__((ext_vector_type(8)));
typedef float f32x4 __attribute__((ext_vector_type(4)));
typedef unsigned u32x4 __attribute__((ext_vector_type(4)));
constexpr int BM = 256, BK = 64, HALF = 128, HTB = HALF * BK * 2  , STAGE_BYTES = 8 * HTB, NXCD = 8, WGM = 8;

__host__ __device__ __forceinline__ int lds_byte(int r, int c) { const int st = (r >> 4) * 2 + (c >> 5), rr = r & 15, cc = c & 31, ob = rr * 64 + cc * 2; return st * 1024 + (ob ^ (((ob >> 9) & 1) << 5)); }
__host__ __device__ __forceinline__ void stage_rc(int b, int& R, int& C) { const int st = b / 1024, sb = b % 1024, swz = sb ^ (((sb >> 9) & 1) << 5); R = (st >> 1) * 16 + swz / 64; C = (st & 1) * 32 + (swz % 64) / 2; }
__host__ __device__ __forceinline__ int perm32(int rho) { const int n = rho >> 4, i = rho & 15; return 8 * (i >> 2) + 4 * n + (i & 3); }

struct Unit { int pm, pn; };
struct Gemm { const bf16_t* A; const bf16_t* Bt; int M, N, K; };

struct StaticOrder {
    int nM, nN, nwg, G, c;
    __host__ __device__ void init(int M, int N, int G_, int c_) { nM = M / BM; nN = N / BM; nwg = nM * nN; G = G_; c = c_; }
    __host__ __device__ bool next(int i, Unit& u) const {
        const long L = (long)i * G + c; if (L >= nwg) return false;
        int wgid = (int)L; { const int q = nwg / NXCD, r = nwg % NXCD, xcd = wgid % NXCD, off = wgid / NXCD; wgid = (xcd < r ? xcd * (q + 1) : r * (q + 1) + (xcd - r) * q) + off; }
        const int nig = WGM * nN, gid = wgid / nig, fm = gid * WGM, gsz = (nM - fm) < WGM ? (nM - fm) : WGM;
        u.pm = fm + ((wgid % nig) % gsz); u.pn = (wgid % nig) / gsz; return true;
    }
    __device__ __forceinline__ void a_ready(const Unit&) const {}
    __device__ __forceinline__ void done(const Unit&) const {}
};

__device__ __forceinline__ unsigned cvt_pk_bf16(float lo, float hi) { unsigned r; asm volatile("v_cvt_pk_bf16_f32 %0, %1, %2" : "=v"(r) : "v"(lo), "v"(hi)); return r; }
template <class Epi, class Sched, bool ALIGN_EPI = false, bool SP2 = false>
__device__ __forceinline__ void gemm_phase(PG8_LAS unsigned char* lds, const Gemm g, const Sched& S, const Epi& E) {
    int tid_l = threadIdx.x; asm volatile("" : "+v"(tid_l));
    const int tid = tid_l, wid = __builtin_amdgcn_readfirstlane(tid >> 6), lane = tid & 63, wr = wid >> 2, wc = wid & 3, fr = lane & 15, fq = lane >> 4;
    const int K = g.K, nt = K / BK;
    unsigned voffA[2], voffB[2];
#pragma unroll
    for (int i = 0; i < 2; ++i) { int R, C; stage_rc(tid * 16 + i * 8192, R, C); const int Rb = Epi::PERM ? ((R & ~31) + perm32(R & 31)) : R;
        voffA[i] = (unsigned)(R * K + C) * 2u; voffB[i] = (unsigned)(Rb * K + C) * 2u; }
    const size_t kstep = (size_t)(BK * 2);
    const size_t hstep = (size_t)HALF * K * 2;
    const size_t tstep = 2 * hstep;
    const unsigned ldsw = (unsigned)wid * 1024u;
    const int aoff = lds_byte(wr * 64 + fr, fq * 8), boff = lds_byte(wc * 32 + fr, fq * 8);
#define PG8_SA(b, h) (((b) * 2 + (h)) * HTB)
#define PG8_SB(b, h) ((4 + (b) * 2 + (h)) * HTB)
#define PG8_STAGE(bufoff, gbase, voff) do { _Pragma("unroll") for (int _i = 0; _i < 2; ++_i) \
        __builtin_amdgcn_global_load_lds((const unsigned*)((const char*)(gbase) + (voff)[_i]), (PG8_LAS unsigned*)(lds + (bufoff) + ldsw + _i * 8192), 16, 0, 0); } while (0)
#define PG8_LDA(dst, b, h) do { _Pragma("unroll") for (int m = 0; m < 4; ++m) _Pragma("unroll") for (int k = 0; k < 2; ++k) dst[m][k] = *(const PG8_LAS bf16x8*)(lds + PG8_SA(b, h) + aoff + m * 2048 + k * 1024); } while (0)
#define PG8_LDB(dst, b, h) do { _Pragma("unroll") for (int n = 0; n < 2; ++n) _Pragma("unroll") for (int k = 0; k < 2; ++k) dst[n][k] = *(const PG8_LAS bf16x8*)(lds + PG8_SB(b, h) + boff + n * 2048 + k * 1024); } while (0)
#define PG8_MMA(ai, bj, At, Bt) do { __builtin_amdgcn_s_setprio(1); _Pragma("unroll") for (int m = 0; m < 4; ++m) _Pragma("unroll") for (int n = 0; n < 2; ++n) _Pragma("unroll") for (int k = 0; k < 2; ++k) \
        acc[ai][bj][m][n] = __builtin_amdgcn_mfma_f32_16x16x32_bf16(Bt[n][k], At[m][k], acc[ai][bj][m][n], 0, 0, 0); __builtin_amdgcn_s_setprio(0); } while (0)
#define PG8_WAIT_V(n) asm volatile("s_waitcnt vmcnt(" #n ")" ::: "memory")
#define PG8_WAIT_L(n) asm volatile("s_waitcnt lgkmcnt(" #n ")" ::: "memory")
#define PG8_BAR __builtin_amdgcn_s_barrier()
#define PG8_SCHED __builtin_amdgcn_sched_barrier(0)
    Unit cur, nxt; int ui = 0;
    if (!S.next(0, cur)) return;
    f32x4 acc[2][2][4][2];
#pragma unroll
    for (int a = 0; a < 2; ++a)
#pragma unroll
        for (int b = 0; b < 2; ++b)
#pragma unroll
            for (int m = 0; m < 4; ++m)
#pragma unroll
                for (int n = 0; n < 2; ++n) acc[a][b][m][n] = (f32x4){0.f, 0.f, 0.f, 0.f};
    bf16x8 At[4][2], B0[2][2], B1[2][2];
    const char* cA = (const char*)g.A + (size_t)cur.pm * tstep; const char* cB = (const char*)g.Bt + (size_t)cur.pn * tstep;
    S.a_ready(cur);
    if constexpr (SP2) {
        PG8_STAGE(PG8_SB(0, 0), cB, voffB); PG8_STAGE(PG8_SB(0, 1), cB + hstep, voffB); PG8_STAGE(PG8_SA(0, 0), cA, voffA); PG8_STAGE(PG8_SA(0, 1), cA + hstep, voffA);
        if (wr == 1) PG8_BAR;
        PG8_WAIT_V(2); PG8_BAR;
        PG8_STAGE(PG8_SB(1, 0), cB + kstep, voffB); PG8_STAGE(PG8_SA(1, 0), cA + kstep, voffA); PG8_STAGE(PG8_SB(1, 1), cB + hstep + kstep, voffB);
        PG8_WAIT_V(6); PG8_BAR;
    } else {
        PG8_STAGE(PG8_SB(0, 0), cB, voffB); PG8_STAGE(PG8_SA(0, 0), cA, voffA); PG8_STAGE(PG8_SB(0, 1), cB + hstep, voffB); PG8_STAGE(PG8_SA(0, 1), cA + hstep, voffA);
        if (wr == 1) PG8_BAR;
        PG8_WAIT_V(4); PG8_BAR;
        PG8_STAGE(PG8_SB(1, 0), cB + kstep, voffB); PG8_STAGE(PG8_SA(1, 0), cA + kstep, voffA); PG8_STAGE(PG8_SB(1, 1), cB + hstep + kstep, voffB);
        PG8_WAIT_V(6); PG8_BAR;
    }
    for (;;) {
        const bool has_next = S.next(ui + 1, nxt);
        const char* nA = has_next ? (const char*)g.A + (size_t)nxt.pm * tstep : cA; const char* nB = has_next ? (const char*)g.Bt + (size_t)nxt.pn * tstep : cB;
        for (int t = 0; t < nt; t += 2) {
            const bool last = (t == nt - 2);
            const char* a1 = cA + (size_t)(t + 1) * kstep;
            const char* a2 = last ? nA : cA + (size_t)(t + 2) * kstep; const char* b2 = last ? nB : cB + (size_t)(t + 2) * kstep;
            const char* a3 = a2 + kstep; const char* b3 = b2 + kstep;
            if (last && has_next) S.a_ready(nxt);
            if constexpr (SP2) {
            PG8_LDB(B0, 0, 0); PG8_LDB(B1, 0, 1); PG8_SCHED; PG8_LDA(At, 0, 0); PG8_STAGE(PG8_SA(1, 1), a1 + hstep, voffA);
            PG8_WAIT_V(8); PG8_WAIT_L(0); PG8_BAR; PG8_MMA(0, 0, At, B0); PG8_MMA(0, 1, At, B1); PG8_BAR; PG8_SCHED;
            PG8_LDA(At, 0, 1); PG8_STAGE(PG8_SB(0, 0), b2, voffB); PG8_STAGE(PG8_SB(0, 1), b2 + hstep, voffB); PG8_STAGE(PG8_SA(0, 0), a2, voffA);
            PG8_WAIT_V(8); PG8_WAIT_L(0); PG8_BAR; PG8_MMA(1, 0, At, B0); PG8_MMA(1, 1, At, B1); PG8_BAR; PG8_SCHED;
            PG8_LDB(B0, 1, 0); PG8_LDB(B1, 1, 1); PG8_SCHED; PG8_LDA(At, 1, 0); PG8_STAGE(PG8_SA(0, 1), a2 + hstep, voffA);
            PG8_WAIT_V(8); PG8_WAIT_L(0); PG8_BAR; PG8_MMA(0, 0, At, B0); PG8_MMA(0, 1, At, B1); PG8_BAR; PG8_SCHED;
            PG8_LDA(At, 1, 1); PG8_STAGE(PG8_SB(1, 0), b3, voffB); PG8_STAGE(PG8_SB(1, 1), b3 + hstep, voffB); PG8_STAGE(PG8_SA(1, 0), a3, voffA);
            PG8_WAIT_V(8); PG8_WAIT_L(0); PG8_BAR; PG8_MMA(1, 0, At, B0); PG8_MMA(1, 1, At, B1); PG8_BAR; PG8_SCHED;
            } else {
            PG8_LDB(B0, 0, 0); PG8_SCHED; PG8_LDA(At, 0, 0); PG8_STAGE(PG8_SA(1, 1), a1 + hstep, voffA);
            PG8_WAIT_L(8); PG8_BAR; PG8_WAIT_L(0); PG8_MMA(0, 0, At, B0); PG8_BAR; PG8_SCHED;
            PG8_LDB(B1, 0, 1); PG8_STAGE(PG8_SB(0, 0), b2, voffB);
            PG8_BAR; PG8_WAIT_L(0); PG8_MMA(0, 1, At, B1); PG8_BAR;
            PG8_LDA(At, 0, 1); PG8_STAGE(PG8_SA(0, 0), a2, voffA);
            PG8_BAR; PG8_WAIT_L(0); PG8_MMA(1, 0, At, B0); PG8_BAR; PG8_SCHED;
            PG8_STAGE(PG8_SB(0, 1), b2 + hstep, voffB);
            PG8_WAIT_V(6); PG8_BAR; PG8_MMA(1, 1, At, B1); PG8_BAR;
            PG8_LDB(B0, 1, 0); PG8_SCHED; PG8_LDA(At, 1, 0); PG8_STAGE(PG8_SA(0, 1), a2 + hstep, voffA);
            PG8_WAIT_L(8); PG8_BAR; PG8_WAIT_L(0); PG8_MMA(0, 0, At, B0); PG8_BAR; PG8_SCHED;
            PG8_LDB(B1, 1, 1); PG8_STAGE(PG8_SB(1, 0), b3, voffB);
            PG8_BAR; PG8_WAIT_L(0); PG8_MMA(0, 1, At, B1); PG8_BAR;
            PG8_LDA(At, 1, 1); PG8_STAGE(PG8_SA(1, 0), a3, voffA);
            PG8_BAR; PG8_WAIT_L(0); PG8_MMA(1, 0, At, B0); PG8_BAR; PG8_SCHED;
            PG8_STAGE(PG8_SB(1, 1), b3 + hstep, voffB);
            PG8_WAIT_V(6); PG8_BAR; PG8_MMA(1, 1, At, B1); PG8_BAR;
            }
        }
        if constexpr (ALIGN_EPI) { if (wr == 0) PG8_BAR; }
        if constexpr (!Epi::AFTER_DRAIN) { E(acc, cur, wr, wc, fr, fq); S.done(cur); }
        if (!has_next) break;
#pragma unroll
        for (int a = 0; a < 2; ++a)
#pragma unroll
            for (int b = 0; b < 2; ++b)
#pragma unroll
                for (int m = 0; m < 4; ++m)
#pragma unroll
                    for (int n = 0; n < 2; ++n) acc[a][b][m][n] = (f32x4){0.f, 0.f, 0.f, 0.f};
        cur = nxt; cA = nA; cB = nB; ++ui;
        if constexpr (ALIGN_EPI) { if (wr == 1) PG8_BAR; }
    }
    PG8_WAIT_V(0);
    if constexpr (!ALIGN_EPI) { if (wr == 0) PG8_BAR; }
    PG8_BAR;
    if constexpr (Epi::AFTER_DRAIN) { E.fused(acc, cur, wr, wc, fr, fq, lds, wid, lane); S.done(cur); }
#undef PG8_SA
#undef PG8_SB
#undef PG8_STAGE
#undef PG8_LDA
#undef PG8_LDB
#undef PG8_MMA
#undef PG8_WAIT_V
#undef PG8_WAIT_L
#undef PG8_BAR
#undef PG8_SCHED
}
}

constexpr int DM = 2048, NP = 8192, NS = 1024, MR = NP + NS;
constexpr int INC = 6656, HG_OFF = 2560, LR_OFF = 5632;
constexpr int FF = 5632, FF2 = 11264;
constexpr int LCOLS = 2304, LRCOLS = 1024, YRC = 1536;
constexpr size_t O_Y = 0;
constexpr size_t O_PRW = (size_t)MR * DM;
constexpr size_t O_PSH = O_PRW + 2ull * 4 * 12 * 64 * 64;
constexpr size_t O_PHG = O_PSH + 2ull * 4 * 2560;
constexpr size_t O_PLR = O_PHG + 2ull * 4 * 6 * 128 * 128;
constexpr size_t O_PLC = O_PLR + 2ull * 4 * 512;
constexpr size_t O_PFC = O_PLC + 2ull * 4 * 3 * 512;
constexpr size_t O_SRW = O_PFC + 2ull * 4 * 2 * 5632;
constexpr size_t O_SSH = O_SRW + 2ull * 128 * 12 * 64 * 64;
constexpr size_t O_SHG = O_SSH + 2ull * 128 * 2560;
constexpr size_t O_SLR = O_SHG + 2ull * 128 * 6 * 128 * 128;
constexpr size_t O_SLC = O_SLR + 2ull * 128 * 512;
constexpr size_t O_SFC = O_SLC + 2ull * 128 * 3 * 512;
constexpr size_t O_END = O_SFC + 2ull * 128 * 2 * 5632;
static_assert(O_END == 61992960ull, "output size");
constexpr size_t al1m(size_t x) { return (x + 1048575ull) & ~1048575ull; }
constexpr size_t WS_CTL = 0, WS_SS = 4096, CTL_ZERO_BYTES = 262144;
constexpr size_t WS_WIN = 1048576;
constexpr size_t WS_WOUT = WS_WIN + al1m(2ull * INC * DM * 2);
constexpr size_t WS_WUP = WS_WOUT + al1m(2ull * DM * DM * 2);
constexpr size_t WS_WDN = WS_WUP + al1m(2ull * FF2 * DM * 2);
constexpr size_t WS_BL = WS_WDN + al1m(2ull * DM * FF * 2);
constexpr size_t WS_BLRU = WS_BL + al1m(2ull * LCOLS * 256 * 2);
constexpr size_t WS_XB = WS_BLRU + al1m(2ull * LRCOLS * 512 * 2);
constexpr size_t WS_YMIX = WS_XB + al1m((size_t)MR * DM * 2);
constexpr size_t WS_R1 = WS_YMIX + al1m((size_t)MR * DM * 2);
constexpr size_t WS_PROJ = WS_R1;
constexpr size_t WS_AP = WS_PROJ + al1m((size_t)MR * INC * 2);
constexpr size_t WS_XCB = WS_AP + al1m((size_t)MR * 256 * 2);
constexpr size_t WS_L = WS_XCB + al1m((size_t)MR * 512 * 2);
constexpr size_t WS_LR = WS_L + al1m((size_t)MR * LCOLS * 4);
constexpr size_t WS_YRAW = WS_LR + al1m((size_t)MR * LRCOLS * 4);
constexpr size_t WS_RWIN = WS_YRAW + al1m((size_t)MR * YRC * 4);
constexpr size_t HGIMG_HALF = (size_t)2 * 6 * 128 * 21760;
static_assert(HGIMG_HALF <= (size_t)MR * DM * 2 && HGIMG_HALF <= 2ull * INC * DM * 2, "HGRN image overlays");
static_assert(HGIMG_HALF <= (size_t)MR * DM * 4, "HGRN image half fits the y region of d_out");
constexpr size_t WS_END_A = WS_RWIN + al1m((size_t)NP * 12 * 896);
constexpr size_t WS_GV = WS_R1;
constexpr size_t WS_H = WS_GV + al1m((size_t)MR * FF2 * 2);
constexpr size_t WS_END_B = WS_H + al1m((size_t)MR * FF * 2);
constexpr size_t WS_END = WS_END_A > WS_END_B ? WS_END_A : WS_END_B;
constexpr int SS_ELEMS = 5 * MR;
constexpr size_t WS_XBAR = 196608;
static_assert(WS_SS + (size_t)SS_ELEMS * 4 <= WS_XBAR && WS_XBAR + 3456 * 4 <= CTL_ZERO_BYTES, "ctl region");

constexpr int LDS_BYTES = 147456;

#define LAS __attribute__((address_space(3)))
typedef unsigned short bf16;
typedef float f32x4 __attribute__((ext_vector_type(4)));
typedef unsigned u32x4 __attribute__((ext_vector_type(4)));
typedef unsigned u32x2 __attribute__((ext_vector_type(2)));
#define LDS_WAIT() asm volatile("s_waitcnt lgkmcnt(0)" ::: "memory")
#define SCHED_FENCE() __builtin_amdgcn_sched_barrier(0)

__device__ __forceinline__ float bf2f(bf16 v) { return __uint_as_float(((unsigned)v) << 16); }
__device__ __forceinline__ float bfu(unsigned v) { return __uint_as_float(v << 16); }
__device__ __forceinline__ float bflo(unsigned u) { return __uint_as_float(u << 16); }
__device__ __forceinline__ float bfhi(unsigned u) { return __uint_as_float(u & 0xffff0000u); }
__device__ __forceinline__ unsigned pk2(float lo, float hi) { return pg8::cvt_pk_bf16(lo, hi); }
__device__ __forceinline__ bf16 f2bf(float x) { return (bf16)(pk2(x, 0.f) & 0xffffu); }
__device__ __forceinline__ float sigm(float x) { return __builtin_amdgcn_rcpf(1.f + __expf(-x)); }
__device__ __forceinline__ float tanh_f(float x) { return 1.f - 2.f * __builtin_amdgcn_rcpf(1.f + __expf(2.f * x)); }
__device__ __forceinline__ float gelu_tanh(float x) { return x * sigm(1.5957691216f * (x + 0.044715f * x * x * x)); }
__device__ __forceinline__ float wave_sum(float v) {
#pragma unroll
    for (int o = 1; o < 64; o <<= 1) v += __shfl_xor(v, o);
    return v;
}
template <int CTRL> __device__ __forceinline__ float dppf(float x) { return __builtin_bit_cast(float, __builtin_amdgcn_mov_dpp(__builtin_bit_cast(int, x), CTRL, 0xf, 0xf, true)); }
__device__ __forceinline__ float allred16(float v) { v += dppf<0xB1>(v); v += dppf<0x4E>(v); v += dppf<0x141>(v); v += dppf<0x128>(v); return v; }

struct Args { const float* in[37]; float* out; unsigned char* ws; };
__device__ __forceinline__ unsigned char* hgimg_base(const Args& A, int b) { return b < 2 ? (unsigned char*)(A.out + O_Y) : A.ws + WS_WIN - HGIMG_HALF; }
__device__ __forceinline__ int tidx() { int t = threadIdx.x; asm volatile("" : "+v"(t)); return t; }

struct EpiScaleBf16 {
    static constexpr bool PERM = true, AFTER_DRAIN = false;
    bf16* O; int ldc; const float* ss;
    __device__ __forceinline__ void operator()(const pg8::f32x4 (&acc)[2][2][4][2], const pg8::Unit& u, int wr, int wc, int fr, int fq) const {
        const int row0 = u.pm * 256 + wr * 64 + fr, col0 = u.pn * 256 + wc * 32 + 8 * fq;
        float sv[8];
        SCHED_FENCE();
#pragma unroll
        for (int i = 0; i < 8; ++i) sv[i] = ss[row0 + (i >> 2) * 128 + (i & 3) * 16];
        SCHED_FENCE();
#pragma unroll
        for (int ai = 0; ai < 2; ++ai)
#pragma unroll
            for (int m = 0; m < 4; ++m) {
                const int row = row0 + ai * 128 + m * 16;
                const float rs = rsqrtf(sv[ai * 4 + m] * (1.0f / 2048.0f) + 1e-6f);
                bf16* rowp = O + (size_t)row * ldc + col0;
#pragma unroll
                for (int bj = 0; bj < 2; ++bj) {
                    const pg8::f32x4 v0 = acc[ai][bj][m][0] * rs, v1 = acc[ai][bj][m][1] * rs;
                    u32x4 w; w.x = pk2(v0[0], v0[1]); w.y = pk2(v0[2], v0[3]); w.z = pk2(v1[0], v1[1]); w.w = pk2(v1[2], v1[3]);
                    *(u32x4*)(rowp + bj * 128) = w;
                }
            }
    }
};
struct EpiBf16 {
    static constexpr bool PERM = true, AFTER_DRAIN = false;
    bf16* O; int ldc;
    __device__ __forceinline__ void operator()(const pg8::f32x4 (&acc)[2][2][4][2], const pg8::Unit& u, int wr, int wc, int fr, int fq) const {
        const int row0 = u.pm * 256 + wr * 64 + fr, col0 = u.pn * 256 + wc * 32 + 8 * fq;
#pragma unroll
        for (int ai = 0; ai < 2; ++ai)
#pragma unroll
            for (int m = 0; m < 4; ++m) {
                bf16* rowp = O + (size_t)(row0 + ai * 128 + m * 16) * ldc + col0;
#pragma unroll
                for (int bj = 0; bj < 2; ++bj) {
                    const pg8::f32x4 v0 = acc[ai][bj][m][0], v1 = acc[ai][bj][m][1];
                    u32x4 w; w.x = pk2(v0[0], v0[1]); w.y = pk2(v0[2], v0[3]); w.z = pk2(v1[0], v1[1]); w.w = pk2(v1[2], v1[3]);
                    *(u32x4*)(rowp + bj * 128) = w;
                }
            }
    }
};
struct EpiF32 {
    static constexpr bool PERM = false, AFTER_DRAIN = false;
    float* C; int ldc;
    __device__ __forceinline__ void operator()(const pg8::f32x4 (&acc)[2][2][4][2], const pg8::Unit& u, int wr, int wc, int fr, int fq) const {
        const int row0 = u.pm * 256 + wr * 64 + fr, col0 = u.pn * 256 + wc * 32 + 4 * fq;
#pragma unroll
        for (int ai = 0; ai < 2; ++ai)
#pragma unroll
            for (int m = 0; m < 4; ++m) {
                float* rowp = C + (size_t)(row0 + ai * 128 + m * 16) * ldc + col0;
#pragma unroll
                for (int bj = 0; bj < 2; ++bj)
#pragma unroll
                    for (int n = 0; n < 2; ++n) *(pg8::f32x4*)(rowp + bj * 128 + n * 16) = acc[ai][bj][m][n];
            }
    }
};
struct EpiResid {
    static constexpr bool PERM = false, AFTER_DRAIN = false;
    bf16* Xb; float* ss;
    __device__ __forceinline__ void operator()(const pg8::f32x4 (&acc)[2][2][4][2], const pg8::Unit& u, int wr, int wc, int fr, int fq) const {
        const int row0 = u.pm * 256 + wr * 64 + fr, col0 = u.pn * 256 + wc * 32 + 4 * fq;
#pragma unroll
        for (int ai = 0; ai < 2; ++ai) {
            u32x2 old[4][2][2];
            SCHED_FENCE();
#pragma unroll
            for (int m = 0; m < 4; ++m)
#pragma unroll
                for (int bj = 0; bj < 2; ++bj)
#pragma unroll
                    for (int n = 0; n < 2; ++n) old[m][bj][n] = *(const u32x2*)(Xb + (size_t)(row0 + ai * 128 + m * 16) * DM + col0 + bj * 128 + n * 16);
            SCHED_FENCE();
#pragma unroll
            for (int m = 0; m < 4; ++m) {
                const int row = row0 + ai * 128 + m * 16;
                bf16* bp = Xb + (size_t)row * DM + col0;
                float q = 0.f;
#pragma unroll
                for (int bj = 0; bj < 2; ++bj)
#pragma unroll
                    for (int n = 0; n < 2; ++n) {
                        const u32x2 o = old[m][bj][n];
                        pg8::f32x4 x = (pg8::f32x4){bflo(o.x), bfhi(o.x), bflo(o.y), bfhi(o.y)} + acc[ai][bj][m][n];
                        q += (x[0] * x[0] + x[1] * x[1]) + (x[2] * x[2] + x[3] * x[3]);
                        u32x2 w; w.x = pk2(x[0], x[1]); w.y = pk2(x[2], x[3]);
                        *(u32x2*)(bp + bj * 128 + n * 16) = w;
                    }
                q += __shfl_xor(q, 16); q += __shfl_xor(q, 32);
                if (fq == 0) atomicAdd(ss + row, q);
            }
        }
    }
};

__device__ __forceinline__ void p0_transpose_item(const float* W, const float* nw, int K, int N, bf16* WT, LAS float* scr, int item, int lane) {
    const int nblk = N / 32, kb = item / nblk, nb = item % nblk, k0 = 64 * kb, n0 = 32 * nb;
    const int kr = lane >> 3, nq = (lane & 7) * 4;
    f32x4 v[8]; float sc[8];
    SCHED_FENCE();
#pragma unroll
    for (int i = 0; i < 8; ++i) { v[i] = *(const f32x4*)(W + (size_t)(k0 + kr + 8 * i) * N + n0 + nq); sc[i] = nw ? nw[k0 + kr + 8 * i] : 1.f; }
    SCHED_FENCE();
#pragma unroll
    for (int i = 0; i < 8; ++i) { LAS float* d = scr + (kr + 8 * i) * 33 + nq; const f32x4 x = v[i] * sc[i]; d[0] = x[0]; d[1] = x[1]; d[2] = x[2]; d[3] = x[3]; }
    LDS_WAIT(); asm volatile("" ::: "memory");
    const int c = lane & 7;
#pragma unroll
    for (int j = 0; j < 4; ++j) { const int n = (lane >> 3) + 8 * j; const LAS float* s = scr + (8 * c) * 33 + n;
        u32x4 o; o.x = pk2(s[0 * 33], s[1 * 33]); o.y = pk2(s[2 * 33], s[3 * 33]); o.z = pk2(s[4 * 33], s[5 * 33]); o.w = pk2(s[6 * 33], s[7 * 33]);
        *(u32x4*)(WT + (size_t)(n0 + n) * K + k0 + 8 * c) = o; }
    LDS_WAIT(); asm volatile("" ::: "memory");
}

__device__ __forceinline__ void convert_weights(const Args& A, LAS unsigned char* lds, int gw, int NGW, int wave, int lane, int l_first, int n_layers_w, int r_lo = 0, int r_hi = 1 << 30) {
    LAS float* scr = (LAS float*)(lds + wave * 16384);
    constexpr int I_IN = (DM / 64) * (INC / 32), I_OUT = (DM / 64) * (DM / 32), I_UP = (DM / 64) * (FF2 / 32), I_DN = (FF / 64) * (DM / 32);
    constexpr int I_L = I_IN + I_OUT + I_UP + I_DN;
    for (int it = gw; it < n_layers_w * I_L; it += NGW) {
        const int l = l_first + it / I_L; int r = it % I_L;
        if (r < r_lo || r >= r_hi) continue;
        if (r < I_IN) { p0_transpose_item(A.in[9] + (size_t)l * DM * INC, A.in[8] + l * DM, DM, INC, (bf16*)(A.ws + WS_WIN) + (size_t)l * INC * DM, scr, r, lane); continue; } r -= I_IN;
        if (r < I_OUT) { p0_transpose_item(A.in[30] + (size_t)l * DM * DM, nullptr, DM, DM, (bf16*)(A.ws + WS_WOUT) + (size_t)l * DM * DM, scr, r, lane); continue; } r -= I_OUT;
        if (r < I_UP) { p0_transpose_item(A.in[32] + (size_t)l * DM * FF2, A.in[31] + l * DM, DM, FF2, (bf16*)(A.ws + WS_WUP) + (size_t)l * FF2 * DM, scr, r, lane); continue; } r -= I_UP;
        p0_transpose_item(A.in[35] + (size_t)l * FF * DM, nullptr, FF, DM, (bf16*)(A.ws + WS_WDN) + (size_t)l * DM * FF, scr, r, lane);
    }
}
__device__ __forceinline__ void phase_prologue(const Args& A, LAS unsigned char* lds, int gw, int NGW, int gt, int NGT, int wave, int lane) {
    convert_weights(A, lds, gw, NGW, wave, lane, 0, 1);
    for (int i = gt; i < 2 * LCOLS * 32; i += NGT) {
        const int l = i / (LCOLS * 32), r = i % (LCOLS * 32), n = r >> 5, k0 = (r & 31) * 8;
        float v[8];
#pragma unroll
        for (int e = 0; e < 8; ++e) v[e] = 0.f;
        if (n < 768) { if (k0 < 64) {
#pragma unroll
            for (int e = 0; e < 8; ++e) v[e] = A.in[12][((size_t)l * 64 + k0 + e) * 768 + n]; } }
        else if (n < 1536) { if (k0 >= 64 && k0 < 128) {
#pragma unroll
            for (int e = 0; e < 8; ++e) v[e] = A.in[14][((size_t)l * 64 + k0 - 64 + e) * 768 + n - 768]; } }
        else { if (k0 >= 128) {
#pragma unroll
            for (int e = 0; e < 8; ++e) v[e] = A.in[15][((size_t)l * 128 + k0 - 128 + e) * 768 + n - 1536]; } }
        u32x4 o; o.x = pk2(v[0], v[1]); o.y = pk2(v[2], v[3]); o.z = pk2(v[4], v[5]); o.w = pk2(v[6], v[7]);
        *(u32x4*)((bf16*)(A.ws + WS_BL) + ((size_t)l * LCOLS + n) * 256 + k0) = o;
    }
    for (int i = gt; i < 2 * LRCOLS * 64; i += NGT) {
        const int l = i / (LRCOLS * 64), r = i % (LRCOLS * 64), n = r >> 6, k0 = (r & 63) * 8;
        const int hb = (n & 511) >> 6, j = n & 63;
        float v[8];
#pragma unroll
        for (int e = 0; e < 8; ++e) v[e] = 0.f;
        if ((k0 >> 6) == hb) {
            const float* Wg = (n < 512) ? A.in[25] : A.in[27];
#pragma unroll
            for (int e = 0; e < 8; ++e) v[e] = Wg[(((size_t)l * 8 + hb) * 64 + (k0 & 63) + e) * 64 + j];
        }
        u32x4 o; o.x = pk2(v[0], v[1]); o.y = pk2(v[2], v[3]); o.z = pk2(v[4], v[5]); o.w = pk2(v[6], v[7]);
        *(u32x4*)((bf16*)(A.ws + WS_BLRU) + ((size_t)l * LRCOLS + n) * 512 + k0) = o;
    }
    bf16* Xb = (bf16*)(A.ws + WS_XB); float* ss = (float*)(A.ws + WS_SS);
    for (int m = gw; m < MR; m += NGW) {
        const float* src = (m < NP) ? A.in[0] + (size_t)m * DM : A.in[1] + (size_t)(m - NP) * DM;
        float q = 0.f;
        f32x4 xs[8];
        SCHED_FENCE();
#pragma unroll
        for (int i = 0; i < 8; ++i) xs[i] = *(const f32x4*)(src + i * 256 + lane * 4);
        SCHED_FENCE();
#pragma unroll
        for (int i = 0; i < 8; ++i) {
            const f32x4 x = xs[i];
            u32x2 w; w.x = pk2(x[0], x[1]); w.y = pk2(x[2], x[3]);
            *(u32x2*)(Xb + (size_t)m * DM + i * 256 + lane * 4) = w;
            q += (x[0] * x[0] + x[1] * x[1]) + (x[2] * x[2] + x[3] * x[3]);
        }
        q = wave_sum(q);
        if (lane == 0) ss[m] = q;
    }
}

#define ROW_INFO(m) const bool samp = (m) >= NP; const int rb = samp ? ((m) - NP) >> 3 : (m) >> 11; const int rt = samp ? ((m) - NP) & 7 : (m) & 2047; const int rT = samp ? 8 : 2048;

__device__ __forceinline__ void phase_b1a(const Args& A, int l, int gw, int NGW, int lane) {
    const bf16* proj = (const bf16*)(A.ws + WS_PROJ);
    bf16* Ap = (bf16*)(A.ws + WS_AP); bf16* xcb = (bf16*)(A.ws + WS_XCB);
    const float* mu = A.in[10] + l * 2560;
    for (int m = gw; m < MR; m += NGW) {
        ROW_INFO(m)
        const bf16* pr = proj + (size_t)m * INC;
        float xcur[8];
        const int c = lane * 8;
        {
            const int cl = 2304 + lane * 4;
            u32x2 cu, pu = (u32x2){0u, 0u}; f32x4 sq = (f32x4){0.f, 0.f, 0.f, 0.f}, m4;
            u32x4 xr_[4]; f32x4 xs0[4], xs1[4], w0[4], w1[4], b0, b1;
            SCHED_FENCE();
            cu = *(const u32x2*)(pr + cl);
            if (rt > 0) pu = *(const u32x2*)(pr - INC + cl);
            else if (samp) sq = *(const f32x4*)(A.in[3] + ((size_t)l * 128 + rb) * 2560 + cl);
            m4 = *(const f32x4*)(mu + cl);
            b0 = *(const f32x4*)(A.in[24] + l * 512 + c); b1 = *(const f32x4*)(A.in[24] + l * 512 + c + 4);
#pragma unroll
            for (int j = 0; j < 4; ++j) {
                const int tt = rt - 3 + j;
                xr_[j] = (u32x4){0u, 0u, 0u, 0u}; xs0[j] = (f32x4){0.f, 0.f, 0.f, 0.f}; xs1[j] = xs0[j];
                if (tt >= 0) xr_[j] = *(const u32x4*)(pr - (size_t)(3 - j) * INC + LR_OFF + c);
                else if (samp) { const float* sp_ = A.in[6] + (((size_t)l * 128 + rb) * 3 + (tt + 3)) * 512 + c; xs0[j] = *(const f32x4*)sp_; xs1[j] = *(const f32x4*)(sp_ + 4); }
                const float* wp = A.in[23] + ((size_t)l * 4 + j) * 512 + c; w0[j] = *(const f32x4*)wp; w1[j] = *(const f32x4*)(wp + 4);
            }
            SCHED_FENCE();
            {
                float p[4] = {bflo(cu.x), bfhi(cu.x), bflo(cu.y), bfhi(cu.y)}, q[4];
                if (rt > 0) { q[0] = bflo(pu.x); q[1] = bfhi(pu.x); q[2] = bflo(pu.y); q[3] = bfhi(pu.y); }
                else { q[0] = sq[0]; q[1] = sq[1]; q[2] = sq[2]; q[3] = sq[3]; }
                float o[4];
#pragma unroll
                for (int e = 0; e < 4; ++e) { const float xs = p[e] + (q[e] - p[e]) * m4[e]; o[e] = lane < 16 ? tanh_f(xs) : (lane < 32 ? xs : sigm(xs)); }
                u32x2 w; w.x = pk2(o[0], o[1]); w.y = pk2(o[2], o[3]);
                *(u32x2*)(Ap + (size_t)m * 256 + lane * 4) = w;
            }
            float acc[8];
            acc[0] = b0[0]; acc[1] = b0[1]; acc[2] = b0[2]; acc[3] = b0[3]; acc[4] = b1[0]; acc[5] = b1[1]; acc[6] = b1[2]; acc[7] = b1[3];
#pragma unroll
            for (int j = 0; j < 4; ++j) {
                const int tt = rt - 3 + j;
                float x[8];
                if (tt >= 0) { const u32x4 u = xr_[j]; x[0] = bflo(u.x); x[1] = bfhi(u.x); x[2] = bflo(u.y); x[3] = bfhi(u.y); x[4] = bflo(u.z); x[5] = bfhi(u.z); x[6] = bflo(u.w); x[7] = bfhi(u.w); }
                else { x[0] = xs0[j][0]; x[1] = xs0[j][1]; x[2] = xs0[j][2]; x[3] = xs0[j][3]; x[4] = xs1[j][0]; x[5] = xs1[j][1]; x[6] = xs1[j][2]; x[7] = xs1[j][3]; }
                acc[0] += w0[j][0] * x[0]; acc[1] += w0[j][1] * x[1]; acc[2] += w0[j][2] * x[2]; acc[3] += w0[j][3] * x[3];
                acc[4] += w1[j][0] * x[4]; acc[5] += w1[j][1] * x[5]; acc[6] += w1[j][2] * x[6]; acc[7] += w1[j][3] * x[7];
                if (j == 3) {
#pragma unroll
                    for (int e = 0; e < 8; ++e) xcur[e] = x[e]; }
            }
            u32x4 o; o.x = pk2(acc[0], acc[1]); o.y = pk2(acc[2], acc[3]); o.z = pk2(acc[4], acc[5]); o.w = pk2(acc[6], acc[7]);
            *(u32x4*)(xcb + (size_t)m * 512 + c) = o;
            if (rt >= rT - 3) {
                float* dst = A.out + (samp ? O_SLC + (((size_t)l * 128 + rb) * 3 + (rt - (rT - 3))) * 512 : O_PLC + (((size_t)l * 4 + rb) * 3 + (rt - (rT - 3))) * 512) + c;
                *(f32x4*)dst = (f32x4){xcur[0], xcur[1], xcur[2], xcur[3]}; *(f32x4*)(dst + 4) = (f32x4){xcur[4], xcur[5], xcur[6], xcur[7]};
            }
        }
        if (rt == rT - 1) {
            float* dst = A.out + (samp ? O_SSH + ((size_t)l * 128 + rb) * 2560 : O_PSH + ((size_t)l * 4 + rb) * 2560);
#pragma unroll
            for (int i = 0; i < 10; ++i) { const int c = i * 256 + lane * 4; const u32x2 u = *(const u32x2*)(pr + c);
                *(f32x4*)(dst + c) = (f32x4){bflo(u.x), bfhi(u.x), bflo(u.y), bfhi(u.y)}; }
        }
    }
}
#define XB_TMO      128
#define XB_XCNT(j)  (256  + 64 * (j))
#define XB_XSUB(j)  (1280 + 64 * (j))
#define XB_XGEN(j)  (2304 + 64 * (j))
#define XB_TOP      3328
#define XB_TOPGEN   3392
#define XCD_BAR_WORDS 3456
#define XB_SPIN_CAP (1u << 18)

__device__ __forceinline__ unsigned xb_ld(unsigned* p)              { return __hip_atomic_load(p, __ATOMIC_RELAXED, __HIP_MEMORY_SCOPE_AGENT); }
__device__ __forceinline__ unsigned xb_add(unsigned* p, unsigned v) { return __hip_atomic_fetch_add(p, v, __ATOMIC_RELAXED, __HIP_MEMORY_SCOPE_AGENT); }
__device__ __forceinline__ unsigned xb_xcc_id() { return (unsigned)__builtin_amdgcn_s_getreg((3 << 11) | 20) & 0xFu; }
#define XB_SPIN(cond, bar) do { unsigned _sp = 0; while (cond) { __builtin_amdgcn_s_sleep(1); \
    if ((++_sp & 255u) == 0u) { if (xb_ld(&(bar)[XB_TMO])) break; if (_sp > XB_SPIN_CAP) { atomicAdd(&(bar)[XB_TMO], 1u); break; } } } } while (0)

struct XcdBarrier {
    unsigned* bar; unsigned x;
    volatile LAS unsigned* st;
};

__device__ __forceinline__ XcdBarrier xcd_barrier_post(unsigned* bar, volatile LAS unsigned* st) {
    XcdBarrier b; b.bar = bar; b.x = xb_xcc_id(); b.st = st;
    if (threadIdx.x == 0) (void)xb_add(&bar[XB_XCNT(b.x)], 1u);
    return b;
}
__device__ __forceinline__ void xcd_barrier_complete(unsigned* bar, unsigned x, unsigned& nloc, unsigned& nx) {
    const unsigned G = gridDim.x * gridDim.y * gridDim.z;
    unsigned sum, cnt, mine, sp = 0u;
    for (;;) {
        sum = 0u; cnt = 0u; mine = 0u;
#pragma unroll
        for (unsigned j = 0; j < 16; ++j) { const unsigned c = xb_ld(&bar[XB_XCNT(j)]); sum += c; cnt += (c > 0u) ? 1u : 0u; mine = (j == x) ? c : mine; }
        if (sum == G) break;
        __builtin_amdgcn_s_sleep(1);
        if ((++sp & 255u) == 0u) { if (xb_ld(&bar[XB_TMO])) break; if (sp > XB_SPIN_CAP) { atomicAdd(&bar[XB_TMO], 1u); break; } }
    }
    nloc = mine > 0u ? mine : 1u; nx = cnt > 0u ? cnt : 1u;
}

__device__ __forceinline__ void xcd_barrier(const XcdBarrier& b) {
    asm volatile("s_waitcnt vmcnt(0)" ::: "memory");
    __syncthreads();
    if (threadIdx.x == 0) {
        unsigned* bar = b.bar;
        __builtin_amdgcn_s_waitcnt(0);
        unsigned nloc = b.st[0], nx = b.st[1];
        if (nloc == 0u) { xcd_barrier_complete(bar, b.x, nloc, nx); b.st[0] = nloc; b.st[1] = nx; }
        const unsigned old = xb_add(&bar[XB_XSUB(b.x)], 1u);
        const unsigned gen = old / nloc;
        if (old + 1u == (gen + 1u) * nloc) {
            __builtin_amdgcn_fence(__ATOMIC_RELEASE, "agent");
            asm volatile("s_waitcnt vmcnt(0)" ::: "memory");
            const unsigned og = xb_add(&bar[XB_TOP], 1u);
            const unsigned tg = og / nx;
            if (og + 1u == (tg + 1u) * nx) xb_add(&bar[XB_TOPGEN], 1u);
            else XB_SPIN(xb_ld(&bar[XB_TOPGEN]) == tg, bar);
            __builtin_amdgcn_fence(__ATOMIC_ACQUIRE, "agent");
            xb_add(&bar[XB_XGEN(b.x)], 1u);
            asm volatile("s_waitcnt vmcnt(0)" ::: "memory");
        } else {
            XB_SPIN(xb_ld(&bar[XB_XGEN(b.x)]) == gen, bar);
            __builtin_amdgcn_fence(__ATOMIC_ACQUIRE, "agent");
            asm volatile("s_waitcnt vmcnt(0)" ::: "memory");
        }
    }
    __syncthreads();
}


__device__ __forceinline__ float wave_sum_fast(float v) { const float r = allred16(v);
    return __builtin_bit_cast(float, __builtin_amdgcn_readlane(__builtin_bit_cast(int, r), 0)) + __builtin_bit_cast(float, __builtin_amdgcn_readlane(__builtin_bit_cast(int, r), 16))
         + __builtin_bit_cast(float, __builtin_amdgcn_readlane(__builtin_bit_cast(int, r), 32)) + __builtin_bit_cast(float, __builtin_amdgcn_readlane(__builtin_bit_cast(int, r), 48)); }
__device__ __forceinline__ void phase_b1c(const Args& A, int l, int gw, int NGW, int lane) {
    const bf16* proj = (const bf16*)(A.ws + WS_PROJ);
    const bf16* L = (const bf16*)(A.ws + WS_L);
    unsigned char* rwin = A.ws + WS_RWIN;
    for (int it = gw; it < (NP / 4) * 12; it += NGW) {
        const int h = it % 12, m0 = (it / 12) * 4;
        const int ch = h * 64 + lane;
        unsigned ur[4], uk[4], uv[4], vr[4], vk[4], vv[4], lw[4], la[4];
        SCHED_FENCE();
#pragma unroll
        for (int i = 0; i < 4; ++i) { const int m = m0 + i; const bf16* p = proj + (size_t)m * INC + ch;
            ur[i] = p[0]; uk[i] = p[768]; uv[i] = p[1536];
            if ((m & 2047) > 0) { vr[i] = *(p - INC); vk[i] = *(p - INC + 768); vv[i] = *(p - INC + 1536); } else { vr[i] = 0; vk[i] = 0; vv[i] = 0; }
            lw[i] = L[(size_t)m * LCOLS + ch]; la[i] = L[(size_t)m * LCOLS + 768 + ch]; }
        const float mu_r = A.in[10][l * 2560 + ch], mu_k = A.in[10][l * 2560 + 768 + ch], mu_v = A.in[10][l * 2560 + 1536 + ch];
        const float w0 = A.in[11][l * 768 + ch], a0 = A.in[13][l * 768 + ch], kkw = A.in[16][l * 768 + ch], kaw = A.in[17][l * 768 + ch];
        SCHED_FENCE();
#pragma unroll
        for (int i = 0; i < 4; ++i) { const int m = m0 + i;
            const float fr_ = bfu(ur[i]), fk_ = bfu(uk[i]), fv_ = bfu(uv[i]);
            const float xr = fr_ + (bfu(vr[i]) - fr_) * mu_r, xk = fk_ + (bfu(vk[i]) - fk_) * mu_k, xv = fv_ + (bfu(vv[i]) - fv_) * mu_v;
            const float dec = __expf(-0.6065306597f * sigm(w0 + bfu(lw[i]))); const float a = sigm(a0 + bfu(la[i]));
            const float kku = xk * kkw; const float ssq = wave_sum_fast(kku * kku); const float kk = kku * rsqrtf(fmaxf(ssq, 1e-24f));
            unsigned char* o = rwin + ((size_t)((m >> 11) * 12 + h) * 2048 + (m & 2047)) * 896;
            *(float*)(o + lane * 4) = dec;
            *(bf16*)(o + 256 + lane * 2) = f2bf(xr); *(bf16*)(o + 384 + lane * 2) = f2bf(xk * (1.f + (a - 1.f) * kaw));
            *(bf16*)(o + 512 + lane * 2) = f2bf(-kk); *(bf16*)(o + 640 + lane * 2) = f2bf(kk * a); *(bf16*)(o + 768 + lane * 2) = f2bf(xv); }
    }
}

__device__ __forceinline__ void rwkv_block_item(const Args& A, int l, LAS float* lds, int stream, int qt) {
    const int tid = tidx(), lane = tid & 63, w = __builtin_amdgcn_readfirstlane(tid >> 6), rl = lane >> 4, j = lane & 15;
    const int b = stream / 12, h = stream % 12;
    const size_t row0 = (size_t)b * 2048;
    LAS float* buf = lds;
    LAS float* ybuf = lds + 2 * 16 * 384;
    if (w < 4) {
        __builtin_amdgcn_s_setprio(2);
        f32x4 S = (f32x4){0.f, 0.f, 0.f, 0.f};
        const int vr = w * 4 + rl;
        const bool jb0 = (j & 1) != 0, jb1 = (j & 2) != 0;
        float yp[4];
        const int vrow = qt * 16 + vr;
        __syncthreads();
        for (int c = 0; c < 128; ++c) {
            const LAS float* base = buf + (c & 1) * 6144;
            LAS float* yb = ybuf + (c & 1) * 256;
            f32x4 r4 = *(const LAS f32x4*)(base + j * 4), w4 = *(const LAS f32x4*)(base + 64 + j * 4), k4 = *(const LAS f32x4*)(base + 128 + j * 4), a4 = *(const LAS f32x4*)(base + 192 + j * 4), b4 = *(const LAS f32x4*)(base + 256 + j * 4);
            float vv = base[320 + vrow];
#pragma unroll
            for (int tt = 0; tt < 16; ++tt) {
                f32x4 nr4 = r4, nw4 = w4, nk4 = k4, na4 = a4, nb4 = b4; float nvv = vv;
                if (tt < 15) { const LAS float* bs = base + (tt + 1) * 384 + j * 4;
                    nr4 = *(const LAS f32x4*)(bs); nw4 = *(const LAS f32x4*)(bs + 64); nk4 = *(const LAS f32x4*)(bs + 128); na4 = *(const LAS f32x4*)(bs + 192); nb4 = *(const LAS f32x4*)(bs + 256);
                    nvv = base[(tt + 1) * 384 + 320 + vrow]; }
                float sa = __builtin_fmaf(S[3], a4[3], __builtin_fmaf(S[2], a4[2], __builtin_fmaf(S[1], a4[1], S[0] * a4[0])));
                sa = allred16(sa);
                S = S * w4 + (b4 * sa + k4 * vv);
                yp[tt & 3] = __builtin_fmaf(S[3], r4[3], __builtin_fmaf(S[2], r4[2], __builtin_fmaf(S[1], r4[1], S[0] * r4[0])));
                if ((tt & 3) == 3) {
                    const float a0 = jb0 ? yp[1] : yp[0], b0 = jb0 ? yp[0] : yp[1], a1 = jb0 ? yp[3] : yp[2], b1 = jb0 ? yp[2] : yp[3];
                    const float r01 = a0 + dppf<0xB1>(b0), r23 = a1 + dppf<0xB1>(b1);
                    const float a2 = jb1 ? r23 : r01, b2 = jb1 ? r01 : r23;
                    float r = a2 + dppf<0x4E>(b2);
                    r += dppf<0x124>(r); r += dppf<0x128>(r);
                    yb[(tt - 3 + (j & 3)) * 16 + vr] = r;
                }
                r4 = nr4; w4 = nw4; k4 = nk4; a4 = na4; b4 = nb4; vv = nvv;
            }
            __syncthreads();
        }
        *(f32x4*)(A.out + O_PRW + ((((size_t)l * 4 + b) * 12 + h) * 64 + vrow) * 64 + j * 4) = S;
        __builtin_amdgcn_s_setprio(0);
    } else {
        const int t2 = tid - 256, st = t2 >> 4, j16 = t2 & 15;
        const unsigned char* src = A.ws + WS_RWIN + ((size_t)(b * 12 + h) * 2048) * 896 + (size_t)st * 896;
        float* yraw = (float*)(A.ws + WS_YRAW);
        f32x4 cw; u32x2 cr, ck, ca, cb, cv;
#define RW_LOAD(c) do { SCHED_FENCE(); const unsigned char* p = src + (size_t)(c) * 16 * 896; cw = *(const f32x4*)(p + j16 * 16); cr = *(const u32x2*)(p + 256 + j16 * 8); ck = *(const u32x2*)(p + 384 + j16 * 8); \
        ca = *(const u32x2*)(p + 512 + j16 * 8); cb = *(const u32x2*)(p + 640 + j16 * 8); cv = *(const u32x2*)(p + 768 + j16 * 8); SCHED_FENCE(); } while (0)
#define RW_U4(u) ((f32x4){bflo((u).x), bfhi((u).x), bflo((u).y), bfhi((u).y)})
#define RW_FIN(c) do { LAS float* o = buf + ((c) & 1) * 6144 + st * 384 + j16 * 4; *(LAS f32x4*)(o) = RW_U4(cr); *(LAS f32x4*)(o + 64) = cw; *(LAS f32x4*)(o + 128) = RW_U4(ck); \
        *(LAS f32x4*)(o + 192) = RW_U4(ca); *(LAS f32x4*)(o + 256) = RW_U4(cb); *(LAS f32x4*)(o + 320) = RW_U4(cv); } while (0)
        RW_LOAD(0); RW_FIN(0); RW_LOAD(1);
        __syncthreads();
        for (int c = 0; c < 128; ++c) {
            if (c + 1 < 128) RW_FIN(c + 1);
            if (c + 2 < 128) RW_LOAD(c + 2);
            __syncthreads();
            { const int tt = t2 >> 4, i = t2 & 15; yraw[(row0 + c * 16 + tt) * YRC + h * 64 + qt * 16 + i] = ybuf[(c & 1) * 256 + tt * 16 + i]; }
        }
#undef RW_U4
#undef RW_LOAD
#undef RW_FIN
    }
}

typedef short bf16x8v __attribute__((ext_vector_type(8)));
typedef __bf16 bf16x2n __attribute__((ext_vector_type(2)));
typedef float f32x2n __attribute__((ext_vector_type(2)));
__device__ __forceinline__ unsigned pk2n(float lo, float hi) { const f32x2n v = {lo, hi}; return __builtin_bit_cast(unsigned, __builtin_convertvector(v, bf16x2n)); }
template <int CTRL> __device__ __forceinline__ float qperm(float x) { return __builtin_bit_cast(float, __builtin_amdgcn_mov_dpp(__builtin_bit_cast(int, x), CTRL, 0xf, 0xf, true)); }
__device__ __forceinline__ void hgrn_mfma_item(const Args& A, int l, LAS unsigned char* lds, const bool samp, int b, int h) {
    const int tid = tidx(), lane = tid & 63, w = __builtin_amdgcn_readfirstlane(tid >> 6), n = lane & 15, g = lane >> 4;
    const size_t row0 = samp ? (size_t)NP + (size_t)b * 8 : (size_t)b * 2048;
    const int nch = samp ? 1 : 128, nval = samp ? 8 : 16;
    const bf16* proj = (const bf16*)(A.ws + WS_PROJ);
    float* yraw = (float*)(A.ws + WS_YRAW);
    constexpr int QS = 272, OFF_QA = 0, OFF_QM = 4352, OFF_KM = 8704, OFF_KH = 13056, OFF_VT = 17152, OFF_EB = 21248, BUFB = 21760;
    const int tq = lane & 3, ch = 16 * w + (lane >> 2);
    const int c_h = h * 128 + ch;
    const float lb = (l == 0) ? 0.f : sigm(A.in[21][768 + c_h] - A.in[21][c_h]);
    pg8::f32x4 acc[8];
#pragma unroll
    for (int kt = 0; kt < 8; ++kt) acc[kt] = (pg8::f32x4){0.f, 0.f, 0.f, 0.f};
    if (samp) {
        const float* sp = A.in[4] + (((size_t)l * 128 + b) * 6 + h) * 16384 + 16 * w + n;
        SCHED_FENCE();
#pragma unroll
        for (int kt = 0; kt < 8; ++kt)
#pragma unroll
            for (int i = 0; i < 4; ++i) acc[kt][i] = sp[(size_t)(16 * kt + 4 * g + i) * 128];
        SCHED_FENCE();
    }
    unsigned rq[4], rf[4], rv[4];
#define HM_LOAD(c) do { SCHED_FENCE(); if (4 * tq < nval) { _Pragma("unroll") for (int i = 0; i < 4; ++i) { const bf16* p = proj + (row0 + (c) * 16 + 4 * tq + i) * INC + HG_OFF + c_h; rq[i] = p[0]; rf[i] = p[768]; rv[i] = p[1536]; } } \
        else { _Pragma("unroll") for (int i = 0; i < 4; ++i) { rq[i] = 0; rf[i] = 0; rv[i] = 0; } } SCHED_FENCE(); } while (0)
#define HM_FIN(c) do { LAS unsigned char* B = lds + ((c) & 1) * BUFB; \
        float q_[4], k_[4], bl[4]; float run = 0.f; \
        _Pragma("unroll") for (int i = 0; i < 4; ++i) { const float xq = bfu(rq[i]); q_[i] = xq * sigm(xq); const float f = (4 * tq < nval) ? lb + (1.f - lb) * sigm(bfu(rf[i])) : 1.f; k_[i] = 1.f - f; run += __logf(f); bl[i] = run; } \
        const float p1 = qperm<0x90>(run), p2 = qperm<0x40>(run), p3 = qperm<0x00>(run); \
        const float off = (tq >= 1 ? p1 : 0.f) + (tq >= 2 ? p2 : 0.f) + (tq >= 3 ? p3 : 0.f); \
        const float tot = qperm<0xFF>(off + run); const float bm = qperm<0x00>(run) + qperm<0x55>(run); \
        float kh[4]; \
        _Pragma("unroll") for (int i = 0; i < 4; ++i) { const float bt = off + bl[i]; const int t = 4 * tq + i; \
            *(LAS bf16*)(B + OFF_QA + t * QS + ch * 2) = (bf16)pk2n(q_[i] * __expf(bt), 0.f); \
            *(LAS bf16*)(B + OFF_QM + t * QS + ch * 2) = (bf16)pk2n(q_[i] * __expf(bt - bm), 0.f); \
            *(LAS bf16*)(B + OFF_KM + t * QS + ch * 2) = (bf16)pk2n(k_[i] * __expf(bm - bt), 0.f); \
            kh[i] = k_[i] * __expf(tot - bt); } \
        u32x2 wk; wk.x = pk2n(kh[0], kh[1]); wk.y = pk2n(kh[2], kh[3]); *(LAS u32x2*)(B + OFF_KH + ch * 32 + tq * 8) = wk; \
        u32x2 wv; wv.x = rv[0] | (rv[1] << 16); wv.y = rv[2] | (rv[3] << 16); *(LAS u32x2*)(B + OFF_VT + ch * 32 + tq * 8) = wv; \
        if (tq == 0) *(LAS float*)(B + OFF_EB + ch * 4) = __expf(tot); } while (0)
    const unsigned char* img = hgimg_base(A, b) + (size_t)((b * 6 + h) * 128) * BUFB;
    u32x4 ci[3];
#define HC_LOAD(c) do { SCHED_FENCE(); _Pragma("unroll") for (int k = 0; k < 3; ++k) { const int idx = tid + 512 * k; if (idx < BUFB / 16) ci[k] = *(const u32x4*)(img + (size_t)(c) * BUFB + idx * 16); } SCHED_FENCE(); } while (0)
#define HC_PUT(c) do { _Pragma("unroll") for (int k = 0; k < 3; ++k) { const int idx = tid + 512 * k; if (idx < BUFB / 16) *(LAS u32x4*)(lds + ((c) & 1) * BUFB + idx * 16) = ci[k]; } } while (0)
    if (samp) { HM_LOAD(0); HM_FIN(0); } else { HC_LOAD(0); HC_PUT(0); HC_LOAD(1); }
    __syncthreads();
    for (int c = 0; c < nch; ++c) {
        const LAS unsigned char* B = lds + (c & 1) * BUFB;
        u32x2 Lqa0[4], Lqa1[4], Lk2[8]; u32x4 Lkm[4], Lqm[4]; pg8::f32x4 Leb[8];
        SCHED_FENCE();
#pragma unroll
        for (int ks = 0; ks < 4; ++ks) { Lqa0[ks] = *(const LAS u32x2*)(B + OFF_QA + n * QS + (32 * ks + 4 * g) * 2); Lqa1[ks] = *(const LAS u32x2*)(B + OFF_QA + n * QS + (32 * ks + 16 + 4 * g) * 2);
            Lkm[ks] = *(const LAS u32x4*)(B + OFF_KM + n * QS + (32 * ks + 8 * g) * 2); Lqm[ks] = *(const LAS u32x4*)(B + OFF_QM + n * QS + (32 * ks + 8 * g) * 2); }
        const u32x2 v2 = *(const LAS u32x2*)(B + OFF_VT + (16 * w + n) * 32 + g * 8);
#pragma unroll
        for (int kt = 0; kt < 8; ++kt) { Leb[kt] = *(const LAS pg8::f32x4*)(B + OFF_EB + (16 * kt + 4 * g) * 4); Lk2[kt] = *(const LAS u32x2*)(B + OFF_KH + (16 * kt + n) * 32 + g * 8); }
        SCHED_FENCE();
        pg8::f32x4 O = (pg8::f32x4){0.f, 0.f, 0.f, 0.f}, At = (pg8::f32x4){0.f, 0.f, 0.f, 0.f};
#pragma unroll
        for (int ks = 0; ks < 4; ++ks) {
            const u32x2 qa0 = Lqa0[ks], qa1 = Lqa1[ks];
            u32x4 qa; qa.x = qa0.x; qa.y = qa0.y; qa.z = qa1.x; qa.w = qa1.y;
            u32x4 sb; sb.x = pk2n(acc[2 * ks][0], acc[2 * ks][1]); sb.y = pk2n(acc[2 * ks][2], acc[2 * ks][3]); sb.z = pk2n(acc[2 * ks + 1][0], acc[2 * ks + 1][1]); sb.w = pk2n(acc[2 * ks + 1][2], acc[2 * ks + 1][3]);
            O = __builtin_amdgcn_mfma_f32_16x16x32_bf16(__builtin_bit_cast(bf16x8v, qa), __builtin_bit_cast(bf16x8v, sb), O, 0, 0, 0);
            const u32x4 km = Lkm[ks], qm = Lqm[ks];
            At = __builtin_amdgcn_mfma_f32_16x16x32_bf16(__builtin_bit_cast(bf16x8v, km), __builtin_bit_cast(bf16x8v, qm), At, 0, 0, 0);
        }
        u32x4 af; af.x = pk2n((4 * g + 0 <= n) ? At[0] : 0.f, (4 * g + 1 <= n) ? At[1] : 0.f); af.y = pk2n((4 * g + 2 <= n) ? At[2] : 0.f, (4 * g + 3 <= n) ? At[3] : 0.f); af.z = 0u; af.w = 0u;
        u32x4 vf; vf.x = v2.x; vf.y = v2.y; vf.z = 0u; vf.w = 0u;
        O = __builtin_amdgcn_mfma_f32_16x16x32_bf16(__builtin_bit_cast(bf16x8v, af), __builtin_bit_cast(bf16x8v, vf), O, 0, 0, 0);
        if (4 * g < nval) {
#pragma unroll
            for (int i = 0; i < 4; ++i) yraw[(row0 + c * 16 + 4 * g + i) * YRC + 768 + h * 128 + 16 * w + n] = O[i]; }
#pragma unroll
        for (int kt = 0; kt < 8; ++kt) {
            const pg8::f32x4 eb = Leb[kt];
            const u32x2 k2 = Lk2[kt];
            u32x4 kf; kf.x = k2.x; kf.y = k2.y; kf.z = 0u; kf.w = 0u;
            acc[kt] = __builtin_amdgcn_mfma_f32_16x16x32_bf16(__builtin_bit_cast(bf16x8v, kf), __builtin_bit_cast(bf16x8v, vf), acc[kt] * eb, 0, 0, 0);
        }
        if (c + 1 < nch) HC_PUT(c + 1);
        if (c + 2 < nch) HC_LOAD(c + 2);
        __syncthreads();
    }
#undef HC_LOAD
#undef HC_PUT
#undef HM_LOAD
#undef HM_FIN
#pragma unroll
    for (int kt = 0; kt < 8; ++kt)
#pragma unroll
        for (int i = 0; i < 4; ++i) A.out[(samp ? O_SHG + (((size_t)l * 128 + b) * 6 + h) * 16384 : O_PHG + (((size_t)l * 4 + b) * 6 + h) * 16384) + (size_t)(16 * kt + 4 * g + i) * 128 + 16 * w + n] = acc[kt][i];
}

__device__ __forceinline__ void hgrn_image_items(const Args& A, int l, LAS unsigned char* lds, int G) {
    const int tid = tidx(), lane = tid & 63, w = __builtin_amdgcn_readfirstlane(tid >> 6);
    const bf16* proj = (const bf16*)(A.ws + WS_PROJ);
    constexpr int QS = 272, OFF_QA = 0, OFF_QM = 4352, OFF_KM = 8704, OFF_KH = 13056, OFF_VT = 17152, OFF_EB = 21248, BUFB = 21760;
    const int tq = lane & 3, ch = 16 * w + (lane >> 2);
    unsigned rq[4], rf[4], rv[4];
    int it = blockIdx.x;
    if (it >= 3072) return;
#define HI_LOAD(itm) do { const int b_ = (itm) / 768, h_ = ((itm) >> 7) % 6, c_ = (itm) & 127; SCHED_FENCE(); _Pragma("unroll") for (int i = 0; i < 4; ++i) { \
        const bf16* p = proj + ((size_t)b_ * 2048 + c_ * 16 + 4 * tq + i) * INC + HG_OFF + h_ * 128 + ch; rq[i] = p[0]; rf[i] = p[768]; rv[i] = p[1536]; } SCHED_FENCE(); } while (0)
    HI_LOAD(it);
    for (; it < 3072; it += G) {
        const int b = it / 768, h = (it >> 7) % 6, c = it & 127;
        const int c_h = h * 128 + ch;
        const float lb = (l == 0) ? 0.f : sigm(A.in[21][768 + c_h] - A.in[21][c_h]);
        LAS unsigned char* B = lds;
        {
            float q_[4], k_[4], bl[4]; float run = 0.f;
#pragma unroll
            for (int i = 0; i < 4; ++i) { const float xq = bfu(rq[i]); q_[i] = xq * sigm(xq); const float f = lb + (1.f - lb) * sigm(bfu(rf[i])); k_[i] = 1.f - f; run += __logf(f); bl[i] = run; }
            const float p1 = qperm<0x90>(run), p2 = qperm<0x40>(run), p3 = qperm<0x00>(run);
            const float off = (tq >= 1 ? p1 : 0.f) + (tq >= 2 ? p2 : 0.f) + (tq >= 3 ? p3 : 0.f);
            const float tot = qperm<0xFF>(off + run); const float bm = qperm<0x00>(run) + qperm<0x55>(run);
            float kh[4];
#pragma unroll
            for (int i = 0; i < 4; ++i) { const float bt = off + bl[i]; const int t = 4 * tq + i;
                *(LAS bf16*)(B + OFF_QA + t * QS + ch * 2) = (bf16)pk2n(q_[i] * __expf(bt), 0.f);
                *(LAS bf16*)(B + OFF_QM + t * QS + ch * 2) = (bf16)pk2n(q_[i] * __expf(bt - bm), 0.f);
                *(LAS bf16*)(B + OFF_KM + t * QS + ch * 2) = (bf16)pk2n(k_[i] * __expf(bm - bt), 0.f);
                kh[i] = k_[i] * __expf(tot - bt); }
            u32x2 wk; wk.x = pk2n(kh[0], kh[1]); wk.y = pk2n(kh[2], kh[3]); *(LAS u32x2*)(B + OFF_KH + ch * 32 + tq * 8) = wk;
            u32x2 wv; wv.x = rv[0] | (rv[1] << 16); wv.y = rv[2] | (rv[3] << 16); *(LAS u32x2*)(B + OFF_VT + ch * 32 + tq * 8) = wv;
            if (tq == 0) *(LAS float*)(B + OFF_EB + ch * 4) = __expf(tot);
        }
        if (it + G < 3072) HI_LOAD(it + G);
        __syncthreads();
        unsigned char* dst = hgimg_base(A, b) + (size_t)((b * 6 + h) * 128 + c) * BUFB;
#pragma unroll
        for (int k = 0; k < 3; ++k) { const int idx = tid + 512 * k; if (idx < BUFB / 16) *(u32x4*)(dst + idx * 16) = *(const LAS u32x4*)(B + idx * 16); }
        __syncthreads();
    }
#undef HI_LOAD
}

__device__ __forceinline__ float expm1_neg(float x) { const float p = x * (1.f + x * (0.5f + x * (0.16666667f + x * (0.041666668f + x * (0.0083333338f + x * (0.0013888889f + x * 0.0001984127f)))))); return x > -0.25f ? p : __expf(x) - 1.f; }
#define LRU_AU(gr_, gi_, xc_, a_, u_) do { const float r_ = sigm((gr_) + ba), i_ = sigm((gi_) + bx); const float la_ = -8.0f * r_ * sp; a_ = __expf(la_); \
        u_ = sqrtf(fmaxf(-expm1_neg(2.0f * la_), 0.f)) * (i_ * (xc_)); } while (0)

__device__ __forceinline__ void lru_block_item(const Args& A, int l, LAS float* lds, int b, int cgp) {
    const int tid = tidx(), lane = tid & 63, w = tid >> 6;
    const int c = cgp * 64 + lane;
    const size_t row0 = (size_t)b * 2048 + (size_t)w * 256;
    const bf16* proj = (const bf16*)(A.ws + WS_PROJ); const bf16* xcb = (const bf16*)(A.ws + WS_XCB);
    const bf16* Lr = (const bf16*)(A.ws + WS_LR);
    bf16* ymix = (bf16*)(A.ws + WS_YMIX);
    const float ba = A.in[26][l * 512 + c], bx = A.in[28][l * 512 + c], sp = log1pf(__expf(-A.in[29][l * 512 + c]));
    LAS float* segA = lds; LAS float* segH = lds + 512;
    float Ap = 1.f, hh = 0.f;
    for (int t8 = 0; t8 < 32; ++t8) {
        unsigned gr[8], gi[8], xc[8];
        SCHED_FENCE();
#pragma unroll
        for (int e = 0; e < 8; ++e) { const size_t m = row0 + t8 * 8 + e; gr[e] = Lr[m * LRCOLS + c]; gi[e] = Lr[m * LRCOLS + 512 + c]; xc[e] = xcb[m * 512 + c]; }
        SCHED_FENCE();
#pragma unroll
        for (int e = 0; e < 8; ++e) { float a, u; LRU_AU(bfu(gr[e]), bfu(gi[e]), bfu(xc[e]), a, u); hh = a * hh + u; Ap *= a; }
    }
    segA[w * 64 + lane] = Ap; segH[w * 64 + lane] = hh;
    __syncthreads();
    float hc = 0.f;
    for (int s = 0; s < w; ++s) hc = segA[s * 64 + lane] * hc + segH[s * 64 + lane];
    for (int t8 = 0; t8 < 32; ++t8) {
        unsigned gr[8], gi[8], xc[8], gt[8];
        SCHED_FENCE();
#pragma unroll
        for (int e = 0; e < 8; ++e) { const size_t m = row0 + t8 * 8 + e; gr[e] = Lr[m * LRCOLS + c]; gi[e] = Lr[m * LRCOLS + 512 + c]; xc[e] = xcb[m * 512 + c]; gt[e] = proj[m * INC + LR_OFF + 512 + c]; }
        SCHED_FENCE();
#pragma unroll
        for (int e = 0; e < 8; ++e) { float a, u; LRU_AU(bfu(gr[e]), bfu(gi[e]), bfu(xc[e]), a, u); hc = a * hc + u; ymix[(row0 + t8 * 8 + e) * DM + 1536 + c] = f2bf(hc * gelu_tanh(bfu(gt[e]))); }
    }
    if (w == 7) A.out[O_PLR + ((size_t)l * 4 + b) * 512 + c] = hc;
    __syncthreads();
}

__device__ __forceinline__ void rwkv_wave_item(const Args& A, int l, LAS float* wl, int b, int h, int lane) {
    const bf16* proj = (const bf16*)(A.ws + WS_PROJ);
    const bf16* L = (const bf16*)(A.ws + WS_L);
    float* yraw = (float*)(A.ws + WS_YRAW);
    const int ch = h * 64 + lane;
    const size_t row0 = (size_t)NP + (size_t)b * 8;
    f32x2n S2[32];
    const float* sp = A.in[2] + ((((size_t)l * 128 + b) * 12 + h) * 64 + lane) * 64;
    {
        f32x4 sv[16];
        SCHED_FENCE();
#pragma unroll
        for (int q = 0; q < 16; ++q) sv[q] = *(const f32x4*)(sp + q * 4);
        SCHED_FENCE();
#pragma unroll
        for (int q = 0; q < 16; ++q) { S2[2 * q] = __builtin_shufflevector(sv[q], sv[q], 0, 1); S2[2 * q + 1] = __builtin_shufflevector(sv[q], sv[q], 2, 3); }
    }
    const float mu_r = A.in[10][l * 2560 + ch], mu_k = A.in[10][l * 2560 + 768 + ch], mu_v = A.in[10][l * 2560 + 1536 + ch];
    const float w0 = A.in[11][l * 768 + ch], a0 = A.in[13][l * 768 + ch], kkw = A.in[16][l * 768 + ch], kaw = A.in[17][l * 768 + ch];
    {
        float pr[8], pk[8], pv[8]; unsigned lw[8], la[8], ur[8], uk[8], uv[8];
        const float* sh = A.in[3] + ((size_t)l * 128 + b) * 2560;
        SCHED_FENCE();
#pragma unroll
        for (int t = 0; t < 8; ++t) { const bf16* p = proj + (row0 + t) * INC + ch; ur[t] = p[0]; uk[t] = p[768]; uv[t] = p[1536]; lw[t] = L[(row0 + t) * LCOLS + ch]; la[t] = L[(row0 + t) * LCOLS + 768 + ch]; }
        float qr = sh[ch], qk = sh[768 + ch], qv = sh[1536 + ch];
        SCHED_FENCE();
#pragma unroll
        for (int t = 0; t < 8; ++t) { pr[t] = bfu(ur[t]); pk[t] = bfu(uk[t]); pv[t] = bfu(uv[t]); }
#pragma unroll
        for (int t = 0; t < 8; ++t) {
            const float xr = pr[t] + (qr - pr[t]) * mu_r, xk = pk[t] + (qk - pk[t]) * mu_k, xv = pv[t] + (qv - pv[t]) * mu_v;
            qr = pr[t]; qk = pk[t]; qv = pv[t];
            const float dec = __expf(-0.6065306597f * sigm(w0 + bfu(lw[t]))); const float a = sigm(a0 + bfu(la[t]));
            const float kku = xk * kkw; const float ssq = wave_sum_fast(kku * kku); const float kk = kku * rsqrtf(fmaxf(ssq, 1e-24f));
            LAS float* o = wl + t * 384 + lane;
            o[0] = xr; o[64] = dec; o[128] = xk * (1.f + (a - 1.f) * kaw); o[192] = -kk; o[256] = kk * a; o[320] = xv;
        }
    }
    LDS_WAIT(); __builtin_amdgcn_wave_barrier();
    for (int t = 0; t < 8; ++t) {
        const LAS float* bs = wl + t * 384;
        const float vv = bs[320 + lane];
        f32x2n d0 = {0.f, 0.f}, d1 = {0.f, 0.f};
#pragma unroll
        for (int qb = 0; qb < 4; ++qb) {
            f32x4 a4[4];
            SCHED_FENCE();
#pragma unroll
            for (int j = 0; j < 4; ++j) a4[j] = *(const LAS f32x4*)(bs + 192 + (qb * 4 + j) * 4);
            SCHED_FENCE();
#pragma unroll
            for (int j = 0; j < 4; ++j) { const int q = qb * 4 + j; d0 = S2[2 * q] * __builtin_shufflevector(a4[j], a4[j], 0, 1) + d0; d1 = S2[2 * q + 1] * __builtin_shufflevector(a4[j], a4[j], 2, 3) + d1; }
        }
        const float sa = (d0[0] + d0[1]) + (d1[0] + d1[1]);
        const f32x2n sa2 = {sa, sa}, vv2 = {vv, vv};
        f32x2n y0 = {0.f, 0.f}, y1 = {0.f, 0.f};
#pragma unroll
        for (int qb = 0; qb < 4; ++qb) {
            f32x4 w4[4], k4[4], b4[4], r4[4];
            SCHED_FENCE();
#pragma unroll
            for (int j = 0; j < 4; ++j) { const int o = (qb * 4 + j) * 4; w4[j] = *(const LAS f32x4*)(bs + 64 + o); k4[j] = *(const LAS f32x4*)(bs + 128 + o); b4[j] = *(const LAS f32x4*)(bs + 256 + o); r4[j] = *(const LAS f32x4*)(bs + o); }
            SCHED_FENCE();
#pragma unroll
            for (int j = 0; j < 4; ++j) { const int q = qb * 4 + j;
                f32x2n tl = __builtin_shufflevector(k4[j], k4[j], 0, 1) * vv2, th = __builtin_shufflevector(k4[j], k4[j], 2, 3) * vv2;
                tl = __builtin_shufflevector(b4[j], b4[j], 0, 1) * sa2 + tl; th = __builtin_shufflevector(b4[j], b4[j], 2, 3) * sa2 + th;
                S2[2 * q] = S2[2 * q] * __builtin_shufflevector(w4[j], w4[j], 0, 1) + tl; S2[2 * q + 1] = S2[2 * q + 1] * __builtin_shufflevector(w4[j], w4[j], 2, 3) + th;
                y0 = S2[2 * q] * __builtin_shufflevector(r4[j], r4[j], 0, 1) + y0; y1 = S2[2 * q + 1] * __builtin_shufflevector(r4[j], r4[j], 2, 3) + y1; }
        }
        yraw[(row0 + t) * YRC + ch] = (y0[0] + y0[1]) + (y1[0] + y1[1]);
    }
    float* so = A.out + O_SRW + ((((size_t)l * 128 + b) * 12 + h) * 64 + lane) * 64;
#pragma unroll
    for (int q = 0; q < 16; ++q) *(f32x4*)(so + q * 4) = (f32x4){S2[2 * q][0], S2[2 * q][1], S2[2 * q + 1][0], S2[2 * q + 1][1]};
    __builtin_amdgcn_wave_barrier();
}

__device__ __forceinline__ void hgrn_wave_item(const Args& A, int l, LAS float* wl, int b, int h, int half, int lane) {
    const bf16* proj = (const bf16*)(A.ws + WS_PROJ);
    float* yraw = (float*)(A.ws + WS_YRAW);
    const size_t row0 = (size_t)NP + (size_t)b * 8;
    const int v = half * 64 + lane;
    float S[128];
    const float* sp = A.in[4] + (((size_t)l * 128 + b) * 6 + h) * 16384 + v;
    SCHED_FENCE();
#pragma unroll
    for (int k = 0; k < 128; ++k) S[k] = sp[(size_t)k * 128];
    unsigned vu[8];
#pragma unroll
    for (int t = 0; t < 8; ++t) vu[t] = proj[(row0 + t) * INC + HG_OFF + 1536 + h * 128 + v];
    SCHED_FENCE();
    float vv[8];
#pragma unroll
    for (int t = 0; t < 8; ++t) vv[t] = bfu(vu[t]);
#pragma unroll
    for (int ii = 0; ii < 2; ++ii) {
        const int c = h * 128 + lane + 64 * ii;
        const float lb = (l == 0) ? 0.f : sigm(A.in[21][768 + c] - A.in[21][c]);
        unsigned uq[8], uf[8];
        SCHED_FENCE();
#pragma unroll
        for (int t = 0; t < 8; ++t) { const bf16* p = proj + (row0 + t) * INC + HG_OFF + c; uq[t] = p[0]; uf[t] = p[768]; }
        SCHED_FENCE();
#pragma unroll
        for (int t = 0; t < 8; ++t) { const float pq = bfu(uq[t]), pf = bfu(uf[t]);
            wl[t * 256 + lane + 64 * ii] = pq * sigm(pq); wl[t * 256 + 128 + lane + 64 * ii] = lb + (1.f - lb) * sigm(pf); }
    }
    LDS_WAIT(); __builtin_amdgcn_wave_barrier();
#pragma unroll
    for (int t = 0; t < 8; ++t) {
        const LAS float* bs = wl + t * 256;
        const float x = vv[t];
        float o0 = 0.f, o1 = 0.f;
#pragma unroll
        for (int q = 0; q < 32; ++q) { const f32x4 q4 = *(const LAS f32x4*)(bs + q * 4), f4 = *(const LAS f32x4*)(bs + 128 + q * 4);
#pragma unroll
            for (int e = 0; e < 4; ++e) S[q * 4 + e] = x + f4[e] * (S[q * 4 + e] - x);
            o0 += S[q * 4] * q4[0] + S[q * 4 + 1] * q4[1]; o1 += S[q * 4 + 2] * q4[2] + S[q * 4 + 3] * q4[3]; }
        yraw[(row0 + t) * YRC + 768 + h * 128 + v] = o0 + o1;
    }
    float* so = A.out + O_SHG + (((size_t)l * 128 + b) * 6 + h) * 16384 + v;
#pragma unroll
    for (int k = 0; k < 128; ++k) so[(size_t)k * 128] = S[k];
    __builtin_amdgcn_wave_barrier();
}

__device__ __forceinline__ void lru_wave_item(const Args& A, int l, int b, int cgp, int lane) {
    const int c = cgp * 64 + lane;
    const size_t row0 = (size_t)NP + (size_t)b * 8;
    const bf16* proj = (const bf16*)(A.ws + WS_PROJ); const bf16* xcb = (const bf16*)(A.ws + WS_XCB);
    const bf16* Lr = (const bf16*)(A.ws + WS_LR);
    bf16* ymix = (bf16*)(A.ws + WS_YMIX);
    const float ba = A.in[26][l * 512 + c], bx = A.in[28][l * 512 + c], sp = log1pf(__expf(-A.in[29][l * 512 + c]));
    float hc = A.in[5][((size_t)l * 128 + b) * 512 + c];
    unsigned gr[8], gi[8], xc[8], gt[8];
    SCHED_FENCE();
#pragma unroll
    for (int e = 0; e < 8; ++e) { const size_t m = row0 + e; gr[e] = Lr[m * LRCOLS + c]; gi[e] = Lr[m * LRCOLS + 512 + c]; xc[e] = xcb[m * 512 + c]; gt[e] = proj[m * INC + LR_OFF + 512 + c]; }
    SCHED_FENCE();
#pragma unroll
    for (int e = 0; e < 8; ++e) { float a, u; LRU_AU(bfu(gr[e]), bfu(gi[e]), bfu(xc[e]), a, u); hc = a * hc + u; ymix[(row0 + e) * DM + 1536 + c] = f2bf(hc * gelu_tanh(bfu(gt[e]))); }
    A.out[O_SLR + ((size_t)l * 128 + b) * 512 + c] = hc;
}

constexpr int N_BLOCK_ITEMS = 248, N_DYN_BLOCK_ITEMS = 768, N_WAVE_ITEMS = 1536 + 1024;
__device__ __forceinline__ void phase_b2(const Args& A, int l, LAS unsigned char* lds, int G, int ctr_idx) {
    const int tid = tidx(), lane = tid & 63, wave = __builtin_amdgcn_readfirstlane(tid >> 6);
    for (int bi = blockIdx.x; bi < N_BLOCK_ITEMS; bi += G) {
        if (bi < 192) rwkv_block_item(A, l, (LAS float*)lds, (bi & 7) + 8 * (bi >> 5), (bi >> 3) & 3);
        else if (bi < 224) lru_block_item(A, l, (LAS float*)lds, (bi - 192) >> 3, (bi - 192) & 7);
        else hgrn_mfma_item(A, l, lds, false, (bi - 224) / 6, (bi - 224) % 6);
        __syncthreads();
    }
    unsigned* ctr = (unsigned*)(A.ws + WS_CTL) + 64 * ctr_idx;
    volatile LAS int* slot = (volatile LAS int*)(lds + 131072 + 320 + 64);
    LAS float* wl = (LAS float*)(lds + wave * 12288);
    for (;;) {
        int it = 0;
        if (lane == 0) it = (int)atomicAdd(ctr, 1u);
        it = __builtin_amdgcn_readfirstlane(it);
        if (it >= N_WAVE_ITEMS) break;
        if (it < 1536) rwkv_wave_item(A, l, wl, it / 12, it % 12, lane);
        else { const int r = it - 1536; lru_wave_item(A, l, r >> 3, r & 7, lane); }
    }
    for (;;) {
        __syncthreads();
        if (tid == 0) *slot = (int)atomicAdd(ctr + 16, 1u);
        __syncthreads();
        const int it = *slot;
        if (it >= N_DYN_BLOCK_ITEMS) break;
        hgrn_mfma_item(A, l, lds, true, it / 6, it % 6);
    }
}

__device__ __forceinline__ void phase_b3(const Args& A, int l, int gw, int NGW, int lane) {
    const bf16* proj = (const bf16*)(A.ws + WS_PROJ);
    const bf16* L = (const bf16*)(A.ws + WS_L);
    const float* yraw = (const float*)(A.ws + WS_YRAW);
    bf16* ymix = (bf16*)(A.ws + WS_YMIX);
    for (int idx = gw; idx < MR * 5; idx += NGW) {
        const int m = idx / 5, u = idx % 5;
        if (u < 3) {
            ROW_INFO(m)
            float P_mur[4], P_muk[4], P_muv[4], P_a0[4], P_ka[4], P_rk[4], P_lw[4], P_lb[4];
            float y[4], pr[4], pk[4], pv[4], qr[4], qk[4], qv[4]; unsigned la[4], g[4], ur[4], uk[4], uv[4], vr[4], vk[4], vv[4];
            SCHED_FENCE();
#pragma unroll
            for (int i = 0; i < 4; ++i) {
                const int ch = (u * 4 + i) * 64 + lane;
                y[i] = yraw[(size_t)m * YRC + ch];
                const bf16* p = proj + (size_t)m * INC + ch;
                ur[i] = p[0]; uk[i] = p[768]; uv[i] = p[1536];
                if (rt > 0) { vr[i] = *(p - INC); vk[i] = *(p - INC + 768); vv[i] = *(p - INC + 1536); qr[i] = 0.f; qk[i] = 0.f; qv[i] = 0.f; }
                else if (samp) { const float* sh = A.in[3] + ((size_t)l * 128 + rb) * 2560; qr[i] = sh[ch]; qk[i] = sh[768 + ch]; qv[i] = sh[1536 + ch]; vr[i] = 0; vk[i] = 0; vv[i] = 0; }
                else { qr[i] = 0.f; qk[i] = 0.f; qv[i] = 0.f; vr[i] = 0; vk[i] = 0; vv[i] = 0; }
                la[i] = L[(size_t)m * LCOLS + 768 + ch]; g[i] = L[(size_t)m * LCOLS + 1536 + ch];
                P_mur[i] = A.in[10][l * 2560 + ch]; P_muk[i] = A.in[10][l * 2560 + 768 + ch]; P_muv[i] = A.in[10][l * 2560 + 1536 + ch];
                P_a0[i] = A.in[13][l * 768 + ch]; P_ka[i] = A.in[17][l * 768 + ch]; P_rk[i] = A.in[18][l * 768 + ch]; P_lw[i] = A.in[19][l * 768 + ch]; P_lb[i] = A.in[20][l * 768 + ch];
            }
            SCHED_FENCE();
#pragma unroll
            for (int i = 0; i < 4; ++i) { pr[i] = bfu(ur[i]); pk[i] = bfu(uk[i]); pv[i] = bfu(uv[i]); if (rt > 0) { qr[i] = bfu(vr[i]); qk[i] = bfu(vk[i]); qv[i] = bfu(vv[i]); } }
#pragma unroll
            for (int i = 0; i < 4; ++i) {
                const int ch = (u * 4 + i) * 64 + lane;
                const float mean = wave_sum_fast(y[i]) * (1.f / 64.f); const float d = y[i] - mean; const float var = wave_sum_fast(d * d) * (1.f / 64.f);
                const float yn = d * rsqrtf(var + 64e-5f) * P_lw[i] + P_lb[i];
                const float xr = pr[i] + (qr[i] - pr[i]) * P_mur[i], xk = pk[i] + (qk[i] - pk[i]) * P_muk[i], xv = pv[i] + (qv[i] - pv[i]) * P_muv[i];
                const float a = sigm(P_a0[i] + bfu(la[i]));
                const float kf = xk * (1.f + (a - 1.f) * P_ka[i]);
                const float bsum = wave_sum_fast(xr * kf * P_rk[i]);
                ymix[(size_t)m * DM + ch] = f2bf((yn + bsum * xv) * bfu(g[i]));
            }
        } else {
            float o0[3], o1[3], g0[3], g1[3], n0[3], n1[3]; unsigned h0[3], h1[3];
            SCHED_FENCE();
#pragma unroll
            for (int i = 0; i < 3; ++i) {
                const int c0 = ((u - 3) * 3 + i) * 128 + lane, c1 = c0 + 64;
                o0[i] = yraw[(size_t)m * YRC + 768 + c0]; o1[i] = yraw[(size_t)m * YRC + 768 + c1];
                h0[i] = proj[(size_t)m * INC + HG_OFF + 2304 + c0]; h1[i] = proj[(size_t)m * INC + HG_OFF + 2304 + c1];
                n0[i] = A.in[22][l * 768 + c0]; n1[i] = A.in[22][l * 768 + c1];
            }
            SCHED_FENCE();
#pragma unroll
            for (int i = 0; i < 3; ++i) { g0[i] = bfu(h0[i]); g1[i] = bfu(h1[i]); }
#pragma unroll
            for (int i = 0; i < 3; ++i) {
                const int c0 = ((u - 3) * 3 + i) * 128 + lane, c1 = c0 + 64;
                const float rs = rsqrtf(wave_sum_fast(o0[i] * o0[i] + o1[i] * o1[i]) * (1.f / 128.f) + 1e-6f);
                ymix[(size_t)m * DM + 768 + c0] = f2bf(o0[i] * rs * n0[i] * (g0[i] * sigm(g0[i])));
                ymix[(size_t)m * DM + 768 + c1] = f2bf(o1[i] * rs * n1[i] * (g1[i] * sigm(g1[i])));
            }
        }
    }
}

__device__ __forceinline__ void unpack8(const u32x4 u, float (&x)[8]) { x[0] = bflo(u.x); x[1] = bfhi(u.x); x[2] = bflo(u.y); x[3] = bfhi(u.y); x[4] = bflo(u.z); x[5] = bfhi(u.z); x[6] = bflo(u.w); x[7] = bfhi(u.w); }
__device__ __forceinline__ void phase_d2(const Args& A, int l, int gt, int NGT) {
    const bf16* GV = (const bf16*)(A.ws + WS_GV);
    bf16* H = (bf16*)(A.ws + WS_H);
    for (int it = gt; it < (MR / 8) * 704; it += NGT) {
        const int chunk = it / 704, c = (it % 704) * 8;
        const int m0 = chunk * 8;
        const bool samp = m0 >= NP;
        float cw0[8], cw1[8], cw2[8], cb[8];
        {
            const float* cwp = A.in[33] + (size_t)l * 3 * FF + c; const float* cbp = A.in[34] + (size_t)l * FF + c;
#pragma unroll
            for (int h = 0; h < 2; ++h) { const f32x4 a = *(const f32x4*)(cwp + 4 * h), b = *(const f32x4*)(cwp + FF + 4 * h), d = *(const f32x4*)(cwp + 2 * FF + 4 * h), e = *(const f32x4*)(cbp + 4 * h);
#pragma unroll
                for (int q = 0; q < 4; ++q) { cw0[4 * h + q] = a[q]; cw1[4 * h + q] = b[q]; cw2[4 * h + q] = d[q]; cb[4 * h + q] = e[q]; } }
        }
        float x1[8], x2[8];
        if (!samp) {
            const int t0 = m0 & 2047;
            if (t0 > 0) { unpack8(*(const u32x4*)(GV + (size_t)(m0 - 1) * FF2 + c), x1); unpack8(*(const u32x4*)(GV + (size_t)(m0 - 2) * FF2 + c), x2); }
            else {
#pragma unroll
                for (int e = 0; e < 8; ++e) { x1[e] = 0.f; x2[e] = 0.f; } }
        }
        for (int r4 = 0; r4 < 2; ++r4) {
          u32x4 rawg[4], rawv[4];
          SCHED_FENCE();
#pragma unroll
          for (int q = 0; q < 4; ++q) { const bf16* gp = GV + (size_t)(m0 + r4 * 4 + q) * FF2 + c; rawg[q] = *(const u32x4*)gp; rawv[q] = *(const u32x4*)(gp + FF); }
          SCHED_FENCE();
#pragma unroll
          for (int q = 0; q < 4; ++q) {
            const int r = r4 * 4 + q;
            const int m = m0 + r;
            if (samp && (r & 7) == 0) {
                const int rb = (m - NP) >> 3;
                const float* s = A.in[7] + (((size_t)l * 128 + rb) * 2) * FF + c;
#pragma unroll
                for (int h = 0; h < 2; ++h) { const f32x4 a = *(const f32x4*)(s + 4 * h), b = *(const f32x4*)(s + FF + 4 * h);
#pragma unroll
                    for (int q = 0; q < 4; ++q) { x2[4 * h + q] = a[q]; x1[4 * h + q] = b[q]; } }
            }
            float x0[8], vl[8], o[8];
            unpack8(rawg[q], x0); unpack8(rawv[q], vl);
#pragma unroll
            for (int e = 0; e < 8; ++e) { const float gc = cb[e] + cw0[e] * x2[e] + cw1[e] * x1[e] + cw2[e] * x0[e]; o[e] = gc * sigm(gc) * vl[e]; }
            u32x4 w; w.x = pk2(o[0], o[1]); w.y = pk2(o[2], o[3]); w.z = pk2(o[4], o[5]); w.w = pk2(o[6], o[7]);
            *(u32x4*)(H + (size_t)m * FF + c) = w;
            const int rt = samp ? (r & 7) : (m & 2047), rT = samp ? 8 : 2048;
            if (rt >= rT - 2) {
                const int rb = samp ? (m - NP) >> 3 : m >> 11;
                float* dst = A.out + (samp ? O_SFC + (((size_t)l * 128 + rb) * 2 + (rt - (rT - 2))) * FF : O_PFC + (((size_t)l * 4 + rb) * 2 + (rt - (rT - 2))) * FF) + c;
                *(f32x4*)dst = (f32x4){x0[0], x0[1], x0[2], x0[3]}; *(f32x4*)(dst + 4) = (f32x4){x0[4], x0[5], x0[6], x0[7]};
            }
#pragma unroll
            for (int e = 0; e < 8; ++e) { x2[e] = x1[e]; x1[e] = x0[e]; }
          }
        }
    }
}

__device__ __forceinline__ void phase_final(const Args& A, int gw, int NGW, int lane) {
    float* Y = A.out + O_Y; const bf16* Xb = (const bf16*)(A.ws + WS_XB); const float* ss = (const float*)(A.ws + WS_SS) + 4 * MR;
    for (int m = gw; m < MR; m += NGW) {
        u32x2 xv[8]; f32x4 nf[8];
        SCHED_FENCE();
        const float ssm = ss[m];
#pragma unroll
        for (int i = 0; i < 8; ++i) { xv[i] = *(const u32x2*)(Xb + (size_t)m * DM + i * 256 + lane * 4); nf[i] = *(const f32x4*)(A.in[36] + i * 256 + lane * 4); }
        SCHED_FENCE();
        const float rs = rsqrtf(ssm * (1.f / 2048.f) + 1e-6f);
#pragma unroll
        for (int i = 0; i < 8; ++i) *(f32x4*)(Y + (size_t)m * DM + i * 256 + lane * 4) = (f32x4){bflo(xv[i].x), bfhi(xv[i].x), bflo(xv[i].y), bfhi(xv[i].y)} * rs * nf[i];
    }
}

#ifndef REP_GEMM
#define REP_GEMM 1
#endif
#ifndef REP_B2
#define REP_B2 1
#endif
#ifndef REP_EW
#define REP_EW 1
#endif
__global__ void __launch_bounds__(512, 2) mk_fwd(Args A) {
    extern __shared__ __attribute__((aligned(16))) unsigned char lds_raw[];
    LAS unsigned char* lds = (LAS unsigned char*)lds_raw;
    cg::grid_group grid = cg::this_grid();
    volatile LAS unsigned* MISC = (volatile LAS unsigned*)(lds + 131072 + 320);
    if (threadIdx.x < 32) MISC[threadIdx.x] = 0u;
    __syncthreads();
    XcdBarrier xbar = xcd_barrier_post((unsigned*)(A.ws + WS_XBAR), MISC + 8);
#define GSYNC() xcd_barrier(xbar)
    const int G = gridDim.x, bx = blockIdx.x, NGW = G * 8, NGT = G * 512;
#define TID_VARS const int tid = tidx(), lane = tid & 63, wave = __builtin_amdgcn_readfirstlane(tid >> 6), gw = bx * 8 + wave, gt = bx * 512 + tid; (void)lane; (void)gw; (void)gt;
    float* const ss = (float*)(A.ws + WS_SS);
    bf16* const Xb = (bf16*)(A.ws + WS_XB);

    { TID_VARS phase_prologue(A, lds, gw, NGW, gt, NGT, wave, lane); }
    grid.sync();
    for (int l = 0; l < 2; ++l) {
        for (int rep = 0; rep < REP_GEMM; ++rep) {
            pg8::Gemm g{(const pg8::bf16_t*)(A.ws + WS_XB), (const pg8::bf16_t*)(A.ws + WS_WIN) + (size_t)l * INC * DM, MR, INC, DM};
            pg8::StaticOrder S; S.init(MR, INC, G, bx);
            EpiScaleBf16 E{(bf16*)(A.ws + WS_PROJ), INC, ss + (2 * l) * MR};
            pg8::gemm_phase<EpiScaleBf16, pg8::StaticOrder, true, true>(lds, g, S, E);
            GSYNC();
        }
        for (int rep = 0; rep < REP_EW; ++rep) { TID_VARS phase_b1a(A, l, gw, NGW, lane); GSYNC(); }
        for (int rep = 0; rep < REP_GEMM; ++rep) {
            pg8::Gemm g{(const pg8::bf16_t*)(A.ws + WS_AP), (const pg8::bf16_t*)(A.ws + WS_BL) + (size_t)l * LCOLS * 256, MR, LCOLS, 256};
            pg8::StaticOrder S; S.init(MR, LCOLS, G, bx);
            EpiBf16 E{(bf16*)(A.ws + WS_L), LCOLS};
            pg8::gemm_phase<EpiBf16, pg8::StaticOrder, true, true>(lds, g, S, E);
            pg8::Gemm g2{(const pg8::bf16_t*)(A.ws + WS_XCB), (const pg8::bf16_t*)(A.ws + WS_BLRU) + (size_t)l * LRCOLS * 512, MR, LRCOLS, 512};
            pg8::StaticOrder S2; S2.init(MR, LRCOLS, G, G - 1 - bx);
            EpiBf16 E2{(bf16*)(A.ws + WS_LR), LRCOLS};
            pg8::gemm_phase<EpiBf16, pg8::StaticOrder, true, true>(lds, g2, S2, E2);
            GSYNC();
        }
        { TID_VARS phase_b1c(A, l, gw, NGW, lane); } hgrn_image_items(A, l, lds, G); GSYNC();
        for (int rep = 0; rep < REP_B2; ++rep) { phase_b2(A, l, lds, G, 1 + l + 2 * rep); GSYNC(); }
        for (int rep = 0; rep < REP_EW; ++rep) { TID_VARS phase_b3(A, l, gw, NGW, lane); GSYNC(); }
        {
            pg8::Gemm g{(const pg8::bf16_t*)(A.ws + WS_YMIX), (const pg8::bf16_t*)(A.ws + WS_WOUT) + (size_t)l * DM * DM, MR, DM, DM};
            pg8::StaticOrder S; S.init(MR, DM, G, bx);
            EpiResid E{Xb, ss + (2 * l + 1) * MR};
            pg8::gemm_phase<EpiResid, pg8::StaticOrder, true, true>(lds, g, S, E);
        }
        if (l == 0) {
            const int tid = tidx(), lane = tid & 63, wave = __builtin_amdgcn_readfirstlane(tid >> 6);
            const int first = (G == 256) ? 32 : 0;
            if (bx >= first) convert_weights(A, lds, (bx - first) * 8 + wave, (G - first) * 8, wave, lane, 1, 1, 0, 8704);
        }
        GSYNC();
        for (int rep = 0; rep < REP_GEMM; ++rep) {
            pg8::Gemm g{(const pg8::bf16_t*)(A.ws + WS_XB), (const pg8::bf16_t*)(A.ws + WS_WUP) + (size_t)l * FF2 * DM, MR, FF2, DM};
            pg8::StaticOrder S; S.init(MR, FF2, G, bx);
            EpiScaleBf16 E{(bf16*)(A.ws + WS_GV), FF2, ss + (2 * l + 1) * MR};
            pg8::gemm_phase<EpiScaleBf16, pg8::StaticOrder, true, true>(lds, g, S, E);
            GSYNC();
        }
        for (int rep = 0; rep < REP_EW; ++rep) { TID_VARS phase_d2(A, l, gt, NGT); GSYNC(); }
        {
            pg8::Gemm g{(const pg8::bf16_t*)(A.ws + WS_H), (const pg8::bf16_t*)(A.ws + WS_WDN) + (size_t)l * DM * FF, MR, DM, FF};
            pg8::StaticOrder S; S.init(MR, DM, G, bx);
            EpiResid E{Xb, ss + (2 * l + 2) * MR};
            pg8::gemm_phase<EpiResid, pg8::StaticOrder, true, true>(lds, g, S, E);
        }
        if (l == 0) {
            const int tid = tidx(), lane = tid & 63, wave = __builtin_amdgcn_readfirstlane(tid >> 6);
            const int first = (G == 256) ? 32 : 0;
            if (bx >= first) convert_weights(A, lds, (bx - first) * 8 + wave, (G - first) * 8, wave, lane, 1, 1, 8704, 1 << 30);
        }
        GSYNC();
    }
    { TID_VARS phase_final(A, gw, NGW, lane); }
}

extern "C" void kernel_launch(void* const* d_in, const int* in_sizes, int n_in, void* d_out, int out_size, void* d_ws, size_t ws_size, hipStream_t stream) {
    static int grid = 0;
    if (grid == 0) {
        if (n_in != 37 || (size_t)out_size != O_END || ws_size < WS_END) { fprintf(stderr, "kernel_launch: unexpected shapes: n_in %d out %d ws %zu (need %zu)\n", n_in, out_size, ws_size, (size_t)WS_END); grid = -1; return; }
        int dev = 0, cus = 0, per_cu = 0;
        if (hipGetDevice(&dev) != hipSuccess || hipDeviceGetAttribute(&cus, hipDeviceAttributeMultiprocessorCount, dev) != hipSuccess) { grid = -1; return; }
        if (hipFuncSetAttribute((const void*)mk_fwd, hipFuncAttributeMaxDynamicSharedMemorySize, LDS_BYTES) != hipSuccess) { fprintf(stderr, "kernel_launch: hipFuncSetAttribute failed\n"); grid = -1; return; }
        if (hipOccupancyMaxActiveBlocksPerMultiprocessor(&per_cu, (const void*)mk_fwd, 512, LDS_BYTES) != hipSuccess || per_cu < 1) { fprintf(stderr, "kernel_launch: occupancy query failed (%d)\n", per_cu); (void)hipGetLastError(); grid = -1; return; }
        grid = cus;
    }
    if (grid < 0) return;
    (void)hipMemsetAsync((char*)d_ws + WS_CTL, 0, CTL_ZERO_BYTES, stream);
    Args a{};
    for (int i = 0; i < 37; ++i) a.in[i] = (const float*)d_in[i];
    a.out = (float*)d_out; a.ws = (unsigned char*)d_ws;
    void* args[] = {&a};
    hipError_t e = hipLaunchCooperativeKernel((const void*)mk_fwd, dim3(grid), dim3(512), args, LDS_BYTES, stream);
    if (e != hipSuccess) fprintf(stderr, "kernel_launch: cooperative launch failed: %s (grid %d)\n", hipGetErrorString(e), grid);
}
```

```cpp
#include <hip/hip_runtime.h>
#include <hip/hip_cooperative_groups.h>
#include <cstdio>
#include <cstdint>
namespace cg = cooperative_groups;
namespace pg8 {
#define PG8_LAS __attribute__((address_space(3)))
typedef unsigned short bf16_t;
typedef short bf16x8 __attribute__((ext_vector_type(8)));
typedef float f32x4 __attribute__((ext_vector_type(4)));
typedef unsigned u32x4 __attribute__((ext_vector_type(4)));
constexpr int BM = 256, BK = 64, HALF = 128, HTB = HALF * BK * 2  , STAGE_BYTES = 8 * HTB, NXCD = 8, WGM = 8;

__host__ __device__ __forceinline__ int lds_byte(int r, int c) { const int st = (r >> 4) * 2 + (c >> 5), rr = r & 15, cc = c & 31, ob = rr * 64 + cc * 2; return st * 1024 + (ob ^ (((ob >> 9) & 1) << 5)); }
__host__ __device__ __forceinline__ void stage_rc(int b, int& R, int& C) { const int st = b / 1024, sb = b % 1024, swz = sb ^ (((sb >> 9) & 1) << 5); R = (st >> 1) * 16 + swz / 64; C = (st & 1) * 32 + (swz % 64) / 2; }
__host__ __device__ __forceinline__ int perm32(int rho) { const int n = rho >> 4, i = rho & 15; return 8 * (i >> 2) + 4 * n + (i & 3); }

struct Unit { int pm, pn; };
struct Gemm { const bf16_t* A; const bf16_t* Bt; int M, N, K; };

struct StaticOrder {
    int nM, nN, nwg, G, c;
    __host__ __device__ void init(int M, int N, int G_, int c_) { nM = M / BM; nN = N / BM; nwg = nM * nN; G = G_; c = c_; }
    __host__ __device__ bool next(int i, Unit& u) const {
        const long L = (long)i * G + c; if (L >= nwg) return false;
        int wgid = (int)L; { const int q = nwg / NXCD, r = nwg % NXCD, xcd = wgid % NXCD, off = wgid / NXCD; wgid = (xcd < r ? xcd * (q + 1) : r * (q + 1) + (xcd - r) * q) + off; }
        const int nig = WGM * nN, gid = wgid / nig, fm = gid * WGM, gsz = (nM - fm) < WGM ? (nM - fm) : WGM;
        u.pm = fm + ((wgid % nig) % gsz); u.pn = (wgid % nig) / gsz; return true;
    }
    __device__ __forceinline__ void a_ready(const Unit&) const {}
    __device__ __forceinline__ void done(const Unit&) const {}
};

__device__ __forceinline__ unsigned cvt_pk_bf16(float lo, float hi) { unsigned r; asm volatile("v_cvt_pk_bf16_f32 %0, %1, %2" : "=v"(r) : "v"(lo), "v"(hi)); return r; }
template <class Epi, class Sched, bool ALIGN_EPI = false, bool SP2 = false>
__device__ __forceinline__ void gemm_phase(PG8_LAS unsigned char* lds, const Gemm g, const Sched& S, const Epi& E) {
    int tid_l = threadIdx.x; asm volatile("" : "+v"(tid_l));
    const int tid = tid_l, wid = __builtin_amdgcn_readfirstlane(tid >> 6), lane = tid & 63, wr = wid >> 2, wc = wid & 3, fr = lane & 15, fq = lane >> 4;
    const int K = g.K, nt = K / BK;
    unsigned voffA[2], voffB[2];
#pragma unroll
    for (int i = 0; i < 2; ++i) { int R, C; stage_rc(tid * 16 + i * 8192, R, C); const int Rb = Epi::PERM ? ((R & ~31) + perm32(R & 31)) : R;
        voffA[i] = (unsigned)(R * K + C) * 2u; voffB[i] = (unsigned)(Rb * K + C) * 2u; }
    const size_t kstep = (size_t)(BK * 2);
    const size_t hstep = (size_t)HALF * K * 2;
    const size_t tstep = 2 * hstep;
    const unsigned ldsw = (unsigned)wid * 1024u;
    const int aoff = lds_byte(wr * 64 + fr, fq * 8), boff = lds_byte(wc * 32 + fr, fq * 8);
#define PG8_SA(b, h) (((b) * 2 + (h)) * HTB)
#define PG8_SB(b, h) ((4 + (b) * 2 + (h)) * HTB)
#define PG8_STAGE(bufoff, gbase, voff) do { _Pragma("unroll") for (int _i = 0; _i < 2; ++_i) \
        __builtin_amdgcn_global_load_lds((const unsigned*)((const char*)(gbase) + (voff)[_i]), (PG8_LAS unsigned*)(lds + (bufoff) + ldsw + _i * 8192), 16, 0, 0); } while (0)
#define PG8_LDA(dst, b, h) do { _Pragma("unroll") for (int m = 0; m < 4; ++m) _Pragma("unroll") for (int k = 0; k < 2; ++k) dst[m][k] = *(const PG8_LAS bf16x8*)(lds + PG8_SA(b, h) + aoff + m * 2048 + k * 1024); } while (0)
#define PG8_LDB(dst, b, h) do { _Pragma("unroll") for (int n = 0; n < 2; ++n) _Pragma("unroll") for (int k = 0; k < 2; ++k) dst[n][k] = *(const PG8_LAS bf16x8*)(lds + PG8_SB(b, h) + boff + n * 2048 + k * 1024); } while (0)
#define PG8_MMA(ai, bj, At, Bt) do { __builtin_amdgcn_s_setprio(1); _Pragma("unroll") for (int m = 0; m < 4; ++m) _Pragma("unroll") for (int n = 0; n < 2; ++n) _Pragma("unroll") for (int k = 0; k < 2; ++k) \
        acc[ai][bj][m][n] = __builtin_amdgcn_mfma_f32_16x16x32_bf16(Bt[n][k], At[m][k], acc[ai][bj][m][n], 0, 0, 0); __builtin_amdgcn_s_setprio(0); } while (0)
#define PG8_WAIT_V(n) asm volatile("s_waitcnt vmcnt(" #n ")" ::: "memory")
#define PG8_WAIT_L(n) asm volatile("s_waitcnt lgkmcnt(" #n ")" ::: "memory")
#define PG8_BAR __builtin_amdgcn_s_barrier()
#define PG8_SCHED __builtin_amdgcn_sched_barrier(0)
    Unit cur, nxt; int ui = 0;
    if (!S.next(0, cur)) return;
    f32x4 acc[2][2][4][2];
#pragma unroll
    for (int a = 0; a < 2; ++a)
#pragma unroll
        for (int b = 0; b < 2; ++b)
#pragma unroll
            for (int m = 0; m < 4; ++m)
#pragma unroll
                for (int n = 0; n < 2; ++n) acc[a][b][m][n] = (f32x4){0.f, 0.f, 0.f, 0.f};
    bf16x8 At[4][2], B0[2][2], B1[2][2];
    const char* cA = (const char*)g.A + (size_t)cur.pm * tstep; const char* cB = (const char*)g.Bt + (size_t)cur.pn * tstep;
    S.a_ready(cur);
    if constexpr (SP2) {
        PG8_STAGE(PG8_SB(0, 0), cB, voffB); PG8_STAGE(PG8_SB(0, 1), cB + hstep, voffB); PG8_STAGE(PG8_SA(0, 0), cA, voffA); PG8_STAGE(PG8_SA(0, 1), cA + hstep, voffA);
        if (wr == 1) PG8_BAR;
        PG8_WAIT_V(2); PG8_BAR;
        PG8_STAGE(PG8_SB(1, 0), cB + kstep, voffB); PG8_STAGE(PG8_SA(1, 0), cA + kstep, voffA); PG8_STAGE(PG8_SB(1, 1), cB + hstep + kstep, voffB);
        PG8_WAIT_V(6); PG8_BAR;
    } else {
        PG8_STAGE(PG8_SB(0, 0), cB, voffB); PG8_STAGE(PG8_SA(0, 0), cA, voffA); PG8_STAGE(PG8_SB(0, 1), cB + hstep, voffB); PG8_STAGE(PG8_SA(0, 1), cA + hstep, voffA);
        if (wr == 1) PG8_BAR;
        PG8_WAIT_V(4); PG8_BAR;
        PG8_STAGE(PG8_SB(1, 0), cB + kstep, voffB); PG8_STAGE(PG8_SA(1, 0), cA + kstep, voffA); PG8_STAGE(PG8_SB(1, 1), cB + hstep + kstep, voffB);
        PG8_WAIT_V(6); PG8_BAR;
    }
    for (;;) {
        const bool has_next = S.next(ui + 1, nxt);
        const char* nA = has_next ? (const char*)g.A + (size_t)nxt.pm * tstep : cA; const char* nB = has_next ? (const char*)g.Bt + (size_t)nxt.pn * tstep : cB;
        for (int t = 0; t < nt; t += 2) {
            const bool last = (t == nt - 2);
            const char* a1 = cA + (size_t)(t + 1) * kstep;
            const char* a2 = last ? nA : cA + (size_t)(t + 2) * kstep; const char* b2 = last ? nB : cB + (size_t)(t + 2) * kstep;
            const char* a3 = a2 + kstep; const char* b3 = b2 + kstep;
            if (last && has_next) S.a_ready(nxt);
            if constexpr (SP2) {
            PG8_LDB(B0, 0, 0); PG8_LDB(B1, 0, 1); PG8_SCHED; PG8_LDA(At, 0, 0); PG8_STAGE(PG8_SA(1, 1), a1 + hstep, voffA);
            PG8_WAIT_V(8); PG8_WAIT_L(0); PG8_BAR; PG8_MMA(0, 0, At, B0); PG8_MMA(0, 1, At, B1); PG8_BAR; PG8_SCHED;
            PG8_LDA(At, 0, 1); PG8_STAGE(PG8_SB(0, 0), b2, voffB); PG8_STAGE(PG8_SB(0, 1), b2 + hstep, voffB); PG8_STAGE(PG8_SA(0, 0), a2, voffA);
            PG8_WAIT_V(8); PG8_WAIT_L(0); PG8_BAR; PG8_MMA(1, 0, At, B0); PG8_MMA(1, 1, At, B1); PG8_BAR; PG8_SCHED;
            PG8_LDB(B0, 1, 0); PG8_LDB(B1, 1, 1); PG8_SCHED; PG8_LDA(At, 1, 0); PG8_STAGE(PG8_SA(0, 1), a2 + hstep, voffA);
            PG8_WAIT_V(8); PG8_WAIT_L(0); PG8_BAR; PG8_MMA(0, 0, At, B0); PG8_MMA(0, 1, At, B1); PG8_BAR; PG8_SCHED;
            PG8_LDA(At, 1, 1); PG8_STAGE(PG8_SB(1, 0), b3, voffB); PG8_STAGE(PG8_SB(1, 1), b3 + hstep, voffB); PG8_STAGE(PG8_SA(1, 0), a3, voffA);
            PG8_WAIT_V(8); PG8_WAIT_L(0); PG8_BAR; PG8_MMA(1, 0, At, B0); PG8_MMA(1, 1, At, B1); PG8_BAR; PG8_SCHED;
            } else {
            PG8_LDB(B0, 0, 0); PG8_SCHED; PG8_LDA(At, 0, 0); PG8_STAGE(PG8_SA(1, 1), a1 + hstep, voffA);
            PG8_WAIT_L(8); PG8_BAR; PG8_WAIT_L(0); PG8_MMA(0, 0, At, B0); PG8_BAR; PG8_SCHED;
            PG8_LDB(B1, 0, 1); PG8_STAGE(PG8_SB(0, 0), b2, voffB);
            PG8_BAR; PG8_WAIT_L(0); PG8_MMA(0, 1, At, B1); PG8_BAR;
            PG8_LDA(At, 0, 1); PG8_STAGE(PG8_SA(0, 0), a2, voffA);
            PG8_BAR; PG8_WAIT_L(0); PG8_MMA(1, 0, At, B0); PG8_BAR; PG8_SCHED;
            PG8_STAGE(PG8_SB(0, 1), b2 + hstep, voffB);
            PG8_WAIT_V(6); PG8_BAR; PG8_MMA(1, 1, At, B1); PG8_BAR;
            PG8_LDB(B0, 1, 0); PG8_SCHED; PG8_LDA(At, 1, 0); PG8_STAGE(PG8_SA(0, 1), a2 + hstep, voffA);
            PG8_WAIT_L(8); PG8_BAR; PG8_WAIT_L(0); PG8_MMA(0, 0, At, B0); PG8_BAR; PG8_SCHED;
            PG8_LDB(B1, 1, 1); PG8_STAGE(PG8_SB(1, 0), b3, voffB);
            PG8_BAR; PG8_WAIT_L(0); PG8_MMA(0, 1, At, B1); PG8_BAR;
            PG8_LDA(At, 1, 1); PG8_STAGE(PG8_SA(1, 0), a3, voffA);
            PG8_BAR; PG8_WAIT_L(0); PG8_MMA(1, 0, At, B0); PG8_BAR; PG8_SCHED;
            PG8_STAGE(PG8_SB(1, 1), b3 + hstep, voffB);
            PG8_WAIT_V(6); PG8_BAR; PG8_MMA(1, 1, At, B1); PG8_BAR;
            }
        }
        if constexpr (ALIGN_EPI) { if (wr == 0) PG8_BAR; }
        if constexpr (!Epi::AFTER_DRAIN) { E(acc, cur, wr, wc, fr, fq); S.done(cur); }
        if (!has_next) break;
#pragma unroll
        for (int a = 0; a < 2; ++a)
#pragma unroll
            for (int b = 0; b < 2; ++b)
#pragma unroll
                for (int m = 0; m < 4; ++m)
#pragma unroll
                    for (int n = 0; n < 2; ++n) acc[a][b][m][n] = (f32x4){0.f, 0.f, 0.f, 0.f};
        cur = nxt; cA = nA; cB = nB; ++ui;
        if constexpr (ALIGN_EPI) { if (wr == 1) PG8_BAR; }
    }
    PG8_WAIT_V(0);
    if constexpr (!ALIGN_EPI) { if (wr == 0) PG8_BAR; }
    PG8_BAR;
    if constexpr (Epi::AFTER_DRAIN) { E.fused(acc, cur, wr, wc, fr, fq, lds, wid, lane); S.done(cur); }
#undef PG8_SA
#undef PG8_SB
#undef PG8_STAGE
#undef PG8_LDA
#undef PG8_LDB
#undef PG8_MMA
#undef PG8_WAIT_V
#undef PG8_WAIT_L
#undef PG8_BAR
#undef PG8_SCHED
}
}

constexpr int DM = 2048, NP = 8192, NS = 1024, MR = NP + NS;
constexpr int INC = 6656, HG_OFF = 2560, LR_OFF = 5632;
constexpr int FF = 5632, FF2 = 11264;
constexpr int LCOLS = 2304, LRCOLS = 1024, YRC = 1536;
constexpr size_t O_Y = 0;
constexpr size_t O_PRW = (size_t)MR * DM;
constexpr size_t O_PSH = O_PRW + 2ull * 4 * 12 * 64 * 64;
constexpr size_t O_PHG = O_PSH + 2ull * 4 * 2560;
constexpr size_t O_PLR = O_PHG + 2ull * 4 * 6 * 128 * 128;
constexpr size_t O_PLC = O_PLR + 2ull * 4 * 512;
constexpr size_t O_PFC = O_PLC + 2ull * 4 * 3 * 512;
constexpr size_t O_SRW = O_PFC + 2ull * 4 * 2 * 5632;
constexpr size_t O_SSH = O_SRW + 2ull * 128 * 12 * 64 * 64;
constexpr size_t O_SHG = O_SSH + 2ull * 128 * 2560;
constexpr size_t O_SLR = O_SHG + 2ull * 128 * 6 * 128 * 128;
constexpr size_t O_SLC = O_SLR + 2ull * 128 * 512;
constexpr size_t O_SFC = O_SLC + 2ull * 128 * 3 * 512;
constexpr size_t O_END = O_SFC + 2ull * 128 * 2 * 5632;
static_assert(O_END == 61992960ull, "output size");
constexpr size_t al1m(size_t x) { return (x + 1048575ull) & ~1048575ull; }
constexpr size_t WS_CTL = 0, WS_SS = 4096, CTL_ZERO_BYTES = 262144;
constexpr size_t WS_WIN = 1048576;
constexpr size_t WS_WOUT = WS_WIN + al1m(2ull * INC * DM * 2);
constexpr size_t WS_WUP = WS_WOUT + al1m(2ull * DM * DM * 2);
constexpr size_t WS_WDN = WS_WUP + al1m(2ull * FF2 * DM * 2);
constexpr size_t WS_BL = WS_WDN + al1m(2ull * DM * FF * 2);
constexpr size_t WS_BLRU = WS_BL + al1m(2ull * LCOLS * 256 * 2);
constexpr size_t WS_XB = WS_BLRU + al1m(2ull * LRCOLS * 512 * 2);
constexpr size_t WS_YMIX = WS_XB + al1m((size_t)MR * DM * 2);
constexpr size_t WS_R1 = WS_YMIX + al1m((size_t)MR * DM * 2);
constexpr size_t WS_PROJ = WS_R1;
constexpr size_t WS_AP = WS_PROJ + al1m((size_t)MR * INC * 2);
constexpr size_t WS_XCB = WS_AP + al1m((size_t)MR * 256 * 2);
constexpr size_t WS_L = WS_XCB + al1m((size_t)MR * 512 * 2);
constexpr size_t WS_LR = WS_L + al1m((size_t)MR * LCOLS * 4);
constexpr size_t WS_YRAW = WS_LR + al1m((size_t)MR * LRCOLS * 4);
constexpr size_t WS_RWIN = WS_YRAW + al1m((size_t)MR * YRC * 4);
constexpr size_t HGIMG_HALF = (size_t)2 * 6 * 128 * 21760;
static_assert(HGIMG_HALF <= (size_t)MR * DM * 2 && HGIMG_HALF <= 2ull * INC * DM * 2, "HGRN image overlays");
static_assert(HGIMG_HALF <= (size_t)MR * DM * 4, "HGRN image half fits the y region of d_out");
constexpr size_t WS_END_A = WS_RWIN + al1m((size_t)NP * 12 * 896);
constexpr size_t WS_GV = WS_R1;
constexpr size_t WS_H = WS_GV + al1m((size_t)MR * FF2 * 2);
constexpr size_t WS_END_B = WS_H + al1m((size_t)MR * FF * 2);
constexpr size_t WS_END = WS_END_A > WS_END_B ? WS_END_A : WS_END_B;
constexpr int SS_ELEMS = 5 * MR;
constexpr size_t WS_XBAR = 196608;
static_assert(WS_SS + (size_t)SS_ELEMS * 4 <= WS_XBAR && WS_XBAR + 3456 * 4 <= CTL_ZERO_BYTES, "ctl region");

constexpr int LDS_BYTES = 147456;

#define LAS __attribute__((address_space(3)))
typedef unsigned short bf16;
typedef float f32x4 __attribute__((ext_vector_type(4)));
typedef unsigned u32x4 __attribute__((ext_vector_type(4)));
typedef unsigned u32x2 __attribute__((ext_vector_type(2)));
#define LDS_WAIT() asm volatile("s_waitcnt lgkmcnt(0)" ::: "memory")
#define SCHED_FENCE() __builtin_amdgcn_sched_barrier(0)

__device__ __forceinline__ float bf2f(bf16 v) { return __uint_as_float(((unsigned)v) << 16); }
__device__ __forceinline__ float bfu(unsigned v) { return __uint_as_float(v << 16); }
__device__ __forceinline__ float bflo(unsigned u) { return __uint_as_float(u << 16); }
__device__ __forceinline__ float bfhi(unsigned u) { return __uint_as_float(u & 0xffff0000u); }
__device__ __forceinline__ unsigned pk2(float lo, float hi) { return pg8::cvt_pk_bf16(lo, hi); }
__device__ __forceinline__ bf16 f2bf(float x) { return (bf16)(pk2(x, 0.f) & 0xffffu); }
__device__ __forceinline__ float sigm(float x) { return __builtin_amdgcn_rcpf(1.f + __expf(-x)); }
__device__ __forceinline__ float tanh_f(float x) { return 1.f - 2.f * __builtin_amdgcn_rcpf(1.f + __expf(2.f * x)); }
__device__ __forceinline__ float gelu_tanh(float x) { return x * sigm(1.5957691216f * (x + 0.044715f * x * x * x)); }
__device__ __forceinline__ float wave_sum(float v) {
#pragma unroll
    for (int o = 1; o < 64; o <<= 1) v += __shfl_xor(v, o);
    return v;
}
template <int CTRL> __device__ __forceinline__ float dppf(float x) { return __builtin_bit_cast(float, __builtin_amdgcn_mov_dpp(__builtin_bit_cast(int, x), CTRL, 0xf, 0xf, true)); }
__device__ __forceinline__ float allred16(float v) { v += dppf<0xB1>(v); v += dppf<0x4E>(v); v += dppf<0x141>(v); v += dppf<0x128>(v); return v; }

struct Args { const float* in[37]; float* out; unsigned char* ws; };
__device__ __forceinline__ unsigned char* hgimg_base(const Args& A, int b) { return b < 2 ? (unsigned char*)(A.out + O_Y) : A.ws + WS_WIN - HGIMG_HALF; }
__device__ __forceinline__ int tidx() { int t = threadIdx.x; asm volatile("" : "+v"(t)); return t; }

struct EpiScaleBf16 {
    static constexpr bool PERM = true, AFTER_DRAIN = false;
    bf16* O; int ldc; const float* ss;
    __device__ __forceinline__ void operator()(const pg8::f32x4 (&acc)[2][2][4][2], const pg8::Unit& u, int wr, int wc, int fr, int fq) const {
        const int row0 = u.pm * 256 + wr * 64 + fr, col0 = u.pn * 256 + wc * 32 + 8 * fq;
#pragma unroll
        for (int ai = 0; ai < 2; ++ai)
#pragma unroll
            for (int m = 0; m < 4; ++m) {
                const int row = row0 + ai * 128 + m * 16;
                const float rs = rsqrtf(ss[row] * (1.0f / 2048.0f) + 1e-6f);
                bf16* rowp = O + (size_t)row * ldc + col0;
#pragma unroll
                for (int bj = 0; bj < 2; ++bj) {
                    const pg8::f32x4 v0 = acc[ai][bj][m][0] * rs, v1 = acc[ai][bj][m][1] * rs;
                    u32x4 w; w.x = pk2(v0[0], v0[1]); w.y = pk2(v0[2], v0[3]); w.z = pk2(v1[0], v1[1]); w.w = pk2(v1[2], v1[3]);
                    *(u32x4*)(rowp + bj * 128) = w;
                }
            }
    }
};
struct EpiBf16 {
    static constexpr bool PERM = true, AFTER_DRAIN = false;
    bf16* O; int ldc;
    __device__ __forceinline__ void operator()(const pg8::f32x4 (&acc)[2][2][4][2], const pg8::Unit& u, int wr, int wc, int fr, int fq) const {
        const int row0 = u.pm * 256 + wr * 64 + fr, col0 = u.pn * 256 + wc * 32 + 8 * fq;
#pragma unroll
        for (int ai = 0; ai < 2; ++ai)
#pragma unroll
            for (int m = 0; m < 4; ++m) {
                bf16* rowp = O + (size_t)(row0 + ai * 128 + m * 16) * ldc + col0;
#pragma unroll
                for (int bj = 0; bj < 2; ++bj) {
                    const pg8::f32x4 v0 = acc[ai][bj][m][0], v1 = acc[ai][bj][m][1];
                    u32x4 w; w.x = pk2(v0[0], v0[1]); w.y = pk2(v0[2], v0[3]); w.z = pk2(v1[0], v1[1]); w.w = pk2(v1[2], v1[3]);
                    *(u32x4*)(rowp + bj * 128) = w;
                }
            }
    }
};
struct EpiF32 {
    static constexpr bool PERM = false, AFTER_DRAIN = false;
    float* C; int ldc;
    __device__ __forceinline__ void operator()(const pg8::f32x4 (&acc)[2][2][4][2], const pg8::Unit& u, int wr, int wc, int fr, int fq) const {
        const int row0 = u.pm * 256 + wr * 64 + fr, col0 = u.pn * 256 + wc * 32 + 4 * fq;
#pragma unroll
        for (int ai = 0; ai < 2; ++ai)
#pragma unroll
            for (int m = 0; m < 4; ++m) {
                float* rowp = C + (size_t)(row0 + ai * 128 + m * 16) * ldc + col0;
#pragma unroll
                for (int bj = 0; bj < 2; ++bj)
#pragma unroll
                    for (int n = 0; n < 2; ++n) *(pg8::f32x4*)(rowp + bj * 128 + n * 16) = acc[ai][bj][m][n];
            }
    }
};
struct EpiResid {
    static constexpr bool PERM = false, AFTER_DRAIN = false;
    bf16* Xb; float* ss;
    __device__ __forceinline__ void operator()(const pg8::f32x4 (&acc)[2][2][4][2], const pg8::Unit& u, int wr, int wc, int fr, int fq) const {
        const int row0 = u.pm * 256 + wr * 64 + fr, col0 = u.pn * 256 + wc * 32 + 4 * fq;
#pragma unroll
        for (int ai = 0; ai < 2; ++ai)
#pragma unroll
            for (int m = 0; m < 4; ++m) {
                const int row = row0 + ai * 128 + m * 16;
                bf16* bp = Xb + (size_t)row * DM + col0;
                float q = 0.f;
#pragma unroll
                for (int bj = 0; bj < 2; ++bj)
#pragma unroll
                    for (int n = 0; n < 2; ++n) {
                        const u32x2 o = *(const u32x2*)(bp + bj * 128 + n * 16);
                        pg8::f32x4 x = (pg8::f32x4){bflo(o.x), bfhi(o.x), bflo(o.y), bfhi(o.y)} + acc[ai][bj][m][n];
                        q += (x[0] * x[0] + x[1] * x[1]) + (x[2] * x[2] + x[3] * x[3]);
                        u32x2 w; w.x = pk2(x[0], x[1]); w.y = pk2(x[2], x[3]);
                        *(u32x2*)(bp + bj * 128 + n * 16) = w;
                    }
                q += __shfl_xor(q, 16); q += __shfl_xor(q, 32);
                if (fq == 0) atomicAdd(ss + row, q);
                if (m & 1) asm volatile("" ::: "memory");
            }
    }
};

__device__ __forceinline__ void p0_transpose_item(const float* W, const float* nw, int K, int N, bf16* WT, LAS float* scr, int item, int lane) {
    const int nblk = N / 32, kb = item / nblk, nb = item % nblk, k0 = 64 * kb, n0 = 32 * nb;
    const int kr = lane >> 3, nq = (lane & 7) * 4;
    f32x4 v[8]; float sc[8];
    SCHED_FENCE();
#pragma unroll
    for (int i = 0; i < 8; ++i) { v[i] = *(const f32x4*)(W + (size_t)(k0 + kr + 8 * i) * N + n0 + nq); sc[i] = nw ? nw[k0 + kr + 8 * i] : 1.f; }
    SCHED_FENCE();
#pragma unroll
    for (int i = 0; i < 8; ++i) { LAS float* d = scr + (kr + 8 * i) * 33 + nq; const f32x4 x = v[i] * sc[i]; d[0] = x[0]; d[1] = x[1]; d[2] = x[2]; d[3] = x[3]; }
    LDS_WAIT(); asm volatile("" ::: "memory");
    const int c = lane & 7;
#pragma unroll
    for (int j = 0; j < 4; ++j) { const int n = (lane >> 3) + 8 * j; const LAS float* s = scr + (8 * c) * 33 + n;
        u32x4 o; o.x = pk2(s[0 * 33], s[1 * 33]); o.y = pk2(s[2 * 33], s[3 * 33]); o.z = pk2(s[4 * 33], s[5 * 33]); o.w = pk2(s[6 * 33], s[7 * 33]);
        *(u32x4*)(WT + (size_t)(n0 + n) * K + k0 + 8 * c) = o; }
    LDS_WAIT(); asm volatile("" ::: "memory");
}

__device__ __forceinline__ void convert_weights(const Args& A, LAS unsigned char* lds, int gw, int NGW, int wave, int lane, int l_first, int n_layers_w, int r_lo = 0, int r_hi = 1 << 30) {
    LAS float* scr = (LAS float*)(lds + wave * 16384);
    constexpr int I_IN = (DM / 64) * (INC / 32), I_OUT = (DM / 64) * (DM / 32), I_UP = (DM / 64) * (FF2 / 32), I_DN = (FF / 64) * (DM / 32);
    constexpr int I_L = I_IN + I_OUT + I_UP + I_DN;
    for (int it = gw; it < n_layers_w * I_L; it += NGW) {
        const int l = l_first + it / I_L; int r = it % I_L;
        if (r < r_lo || r >= r_hi) continue;
        if (r < I_IN) { p0_transpose_item(A.in[9] + (size_t)l * DM * INC, A.in[8] + l * DM, DM, INC, (bf16*)(A.ws + WS_WIN) + (size_t)l * INC * DM, scr, r, lane); continue; } r -= I_IN;
        if (r < I_OUT) { p0_transpose_item(A.in[30] + (size_t)l * DM * DM, nullptr, DM, DM, (bf16*)(A.ws + WS_WOUT) + (size_t)l * DM * DM, scr, r, lane); continue; } r -= I_OUT;
        if (r < I_UP) { p0_transpose_item(A.in[32] + (size_t)l * DM * FF2, A.in[31] + l * DM, DM, FF2, (bf16*)(A.ws + WS_WUP) + (size_t)l * FF2 * DM, scr, r, lane); continue; } r -= I_UP;
        p0_transpose_item(A.in[35] + (size_t)l * FF * DM, nullptr, FF, DM, (bf16*)(A.ws + WS_WDN) + (size_t)l * DM * FF, scr, r, lane);
    }
}
__device__ __forceinline__ void phase_prologue(const Args& A, LAS unsigned char* lds, int gw, int NGW, int gt, int NGT, int wave, int lane) {
    convert_weights(A, lds, gw, NGW, wave, lane, 0, 1, 0, 8704);
    for (int i = gt; i < 2 * LCOLS * 32; i += NGT) {
        const int l = i / (LCOLS * 32), r = i % (LCOLS * 32), n = r >> 5, k0 = (r & 31) * 8;
        float v[8];
#pragma unroll
        for (int e = 0; e < 8; ++e) v[e] = 0.f;
        if (n < 768) { if (k0 < 64) {
#pragma unroll
            for (int e = 0; e < 8; ++e) v[e] = A.in[12][((size_t)l * 64 + k0 + e) * 768 + n]; } }
        else if (n < 1536) { if (k0 >= 64 && k0 < 128) {
#pragma unroll
            for (int e = 0; e < 8; ++e) v[e] = A.in[14][((size_t)l * 64 + k0 - 64 + e) * 768 + n - 768]; } }
        else { if (k0 >= 128) {
#pragma unroll
            for (int e = 0; e < 8; ++e) v[e] = A.in[15][((size_t)l * 128 + k0 - 128 + e) * 768 + n - 1536]; } }
        u32x4 o; o.x = pk2(v[0], v[1]); o.y = pk2(v[2], v[3]); o.z = pk2(v[4], v[5]); o.w = pk2(v[6], v[7]);
        *(u32x4*)((bf16*)(A.ws + WS_BL) + ((size_t)l * LCOLS + n) * 256 + k0) = o;
    }
    for (int i = gt; i < 2 * LRCOLS * 64; i += NGT) {
        const int l = i / (LRCOLS * 64), r = i % (LRCOLS * 64), n = r >> 6, k0 = (r & 63) * 8;
        const int hb = (n & 511) >> 6, j = n & 63;
        float v[8];
#pragma unroll
        for (int e = 0; e < 8; ++e) v[e] = 0.f;
        if ((k0 >> 6) == hb) {
            const float* Wg = (n < 512) ? A.in[25] : A.in[27];
#pragma unroll
            for (int e = 0; e < 8; ++e) v[e] = Wg[(((size_t)l * 8 + hb) * 64 + (k0 & 63) + e) * 64 + j];
        }
        u32x4 o; o.x = pk2(v[0], v[1]); o.y = pk2(v[2], v[3]); o.z = pk2(v[4], v[5]); o.w = pk2(v[6], v[7]);
        *(u32x4*)((bf16*)(A.ws + WS_BLRU) + ((size_t)l * LRCOLS + n) * 512 + k0) = o;
    }
    bf16* Xb = (bf16*)(A.ws + WS_XB); float* ss = (float*)(A.ws + WS_SS);
    for (int m = gw; m < MR; m += NGW) {
        const float* src = (m < NP) ? A.in[0] + (size_t)m * DM : A.in[1] + (size_t)(m - NP) * DM;
        float q = 0.f;
        f32x4 xs[8];
        SCHED_FENCE();
#pragma unroll
        for (int i = 0; i < 8; ++i) xs[i] = *(const f32x4*)(src + i * 256 + lane * 4);
        SCHED_FENCE();
#pragma unroll
        for (int i = 0; i < 8; ++i) {
            const f32x4 x = xs[i];
            u32x2 w; w.x = pk2(x[0], x[1]); w.y = pk2(x[2], x[3]);
            *(u32x2*)(Xb + (size_t)m * DM + i * 256 + lane * 4) = w;
            q += (x[0] * x[0] + x[1] * x[1]) + (x[2] * x[2] + x[3] * x[3]);
        }
        q = wave_sum(q);
        if (lane == 0) ss[m] = q;
    }
}

#define ROW_INFO(m) const bool samp = (m) >= NP; const int rb = samp ? ((m) - NP) >> 3 : (m) >> 11; const int rt = samp ? ((m) - NP) & 7 : (m) & 2047; const int rT = samp ? 8 : 2048;

__device__ __forceinline__ void phase_b1a(const Args& A, int l, int gw, int NGW, int lane) {
    const bf16* proj = (const bf16*)(A.ws + WS_PROJ);
    bf16* Ap = (bf16*)(A.ws + WS_AP); bf16* xcb = (bf16*)(A.ws + WS_XCB);
    const float* mu = A.in[10] + l * 2560;
    for (int m = gw; m < MR; m += NGW) {
        ROW_INFO(m)
        const bf16* pr = proj + (size_t)m * INC;
        float xcur[8];
        const int c = lane * 8;
        {
            const int cl = 2304 + lane * 4;
            u32x2 cu, pu = (u32x2){0u, 0u}; f32x4 sq = (f32x4){0.f, 0.f, 0.f, 0.f}, m4;
            u32x4 xr_[4]; f32x4 xs0[4], xs1[4], w0[4], w1[4], b0, b1;
            SCHED_FENCE();
            cu = *(const u32x2*)(pr + cl);
            if (rt > 0) pu = *(const u32x2*)(pr - INC + cl);
            else if (samp) sq = *(const f32x4*)(A.in[3] + ((size_t)l * 128 + rb) * 2560 + cl);
            m4 = *(const f32x4*)(mu + cl);
            b0 = *(const f32x4*)(A.in[24] + l * 512 + c); b1 = *(const f32x4*)(A.in[24] + l * 512 + c + 4);
#pragma unroll
            for (int j = 0; j < 4; ++j) {
                const int tt = rt - 3 + j;
                xr_[j] = (u32x4){0u, 0u, 0u, 0u}; xs0[j] = (f32x4){0.f, 0.f, 0.f, 0.f}; xs1[j] = xs0[j];
                if (tt >= 0) xr_[j] = *(const u32x4*)(pr - (size_t)(3 - j) * INC + LR_OFF + c);
                else if (samp) { const float* sp_ = A.in[6] + (((size_t)l * 128 + rb) * 3 + (tt + 3)) * 512 + c; xs0[j] = *(const f32x4*)sp_; xs1[j] = *(const f32x4*)(sp_ + 4); }
                const float* wp = A.in[23] + ((size_t)l * 4 + j) * 512 + c; w0[j] = *(const f32x4*)wp; w1[j] = *(const f32x4*)(wp + 4);
            }
            SCHED_FENCE();
            {
                float p[4] = {bflo(cu.x), bfhi(cu.x), bflo(cu.y), bfhi(cu.y)}, q[4];
                if (rt > 0) { q[0] = bflo(pu.x); q[1] = bfhi(pu.x); q[2] = bflo(pu.y); q[3] = bfhi(pu.y); }
                else { q[0] = sq[0]; q[1] = sq[1]; q[2] = sq[2]; q[3] = sq[3]; }
                float o[4];
#pragma unroll
                for (int e = 0; e < 4; ++e) { const float xs = p[e] + (q[e] - p[e]) * m4[e]; o[e] = lane < 16 ? tanh_f(xs) : (lane < 32 ? xs : sigm(xs)); }
                u32x2 w; w.x = pk2(o[0], o[1]); w.y = pk2(o[2], o[3]);
                *(u32x2*)(Ap + (size_t)m * 256 + lane * 4) = w;
            }
            float acc[8];
            acc[0] = b0[0]; acc[1] = b0[1]; acc[2] = b0[2]; acc[3] = b0[3]; acc[4] = b1[0]; acc[5] = b1[1]; acc[6] = b1[2]; acc[7] = b1[3];
#pragma unroll
            for (int j = 0; j < 4; ++j) {
                const int tt = rt - 3 + j;
                float x[8];
                if (tt >= 0) { const u32x4 u = xr_[j]; x[0] = bflo(u.x); x[1] = bfhi(u.x); x[2] = bflo(u.y); x[3] = bfhi(u.y); x[4] = bflo(u.z); x[5] = bfhi(u.z); x[6] = bflo(u.w); x[7] = bfhi(u.w); }
                else { x[0] = xs0[j][0]; x[1] = xs0[j][1]; x[2] = xs0[j][2]; x[3] = xs0[j][3]; x[4] = xs1[j][0]; x[5] = xs1[j][1]; x[6] = xs1[j][2]; x[7] = xs1[j][3]; }
                acc[0] += w0[j][0] * x[0]; acc[1] += w0[j][1] * x[1]; acc[2] += w0[j][2] * x[2]; acc[3] += w0[j][3] * x[3];
                acc[4] += w1[j][0] * x[4]; acc[5] += w1[j][1] * x[5]; acc[6] += w1[j][2] * x[6]; acc[7] += w1[j][3] * x[7];
                if (j == 3) {
#pragma unroll
                    for (int e = 0; e < 8; ++e) xcur[e] = x[e]; }
            }
            u32x4 o; o.x = pk2(acc[0], acc[1]); o.y = pk2(acc[2], acc[3]); o.z = pk2(acc[4], acc[5]); o.w = pk2(acc[6], acc[7]);
            *(u32x4*)(xcb + (size_t)m * 512 + c) = o;
            if (rt >= rT - 3) {
                float* dst = A.out + (samp ? O_SLC + (((size_t)l * 128 + rb) * 3 + (rt - (rT - 3))) * 512 : O_PLC + (((size_t)l * 4 + rb) * 3 + (rt - (rT - 3))) * 512) + c;
                *(f32x4*)dst = (f32x4){xcur[0], xcur[1], xcur[2], xcur[3]}; *(f32x4*)(dst + 4) = (f32x4){xcur[4], xcur[5], xcur[6], xcur[7]};
            }
        }
        if (rt == rT - 1) {
            float* dst = A.out + (samp ? O_SSH + ((size_t)l * 128 + rb) * 2560 : O_PSH + ((size_t)l * 4 + rb) * 2560);
#pragma unroll
            for (int i = 0; i < 10; ++i) { const int c = i * 256 + lane * 4; const u32x2 u = *(const u32x2*)(pr + c);
                *(f32x4*)(dst + c) = (f32x4){bflo(u.x), bfhi(u.x), bflo(u.y), bfhi(u.y)}; }
        }
    }
}
#define XB_TMO      128
#define XB_XCNT(j)  (256  + 64 * (j))
#define XB_XSUB(j)  (1280 + 64 * (j))
#define XB_XGEN(j)  (2304 + 64 * (j))
#define XB_TOP      3328
#define XB_TOPGEN   3392
#define XCD_BAR_WORDS 3456
#define XB_SPIN_CAP (1u << 18)

__device__ __forceinline__ unsigned xb_ld(unsigned* p)              { return __hip_atomic_load(p, __ATOMIC_RELAXED, __HIP_MEMORY_SCOPE_AGENT); }
__device__ __forceinline__ unsigned xb_add(unsigned* p, unsigned v) { return __hip_atomic_fetch_add(p, v, __ATOMIC_RELAXED, __HIP_MEMORY_SCOPE_AGENT); }
__device__ __forceinline__ unsigned xb_xcc_id() { return (unsigned)__builtin_amdgcn_s_getreg((3 << 11) | 20) & 0xFu; }
#define XB_SPIN(cond, bar) do { unsigned _sp = 0; while (cond) { __builtin_amdgcn_s_sleep(1); \
    if ((++_sp & 255u) == 0u) { if (xb_ld(&(bar)[XB_TMO])) break; if (_sp > XB_SPIN_CAP) { atomicAdd(&(bar)[XB_TMO], 1u); break; } } } } while (0)

struct XcdBarrier {
    unsigned* bar; unsigned x;
    volatile LAS unsigned* st;
};

__device__ __forceinline__ XcdBarrier xcd_barrier_post(unsigned* bar, volatile LAS unsigned* st) {
    XcdBarrier b; b.bar = bar; b.x = xb_xcc_id(); b.st = st;
    if (threadIdx.x == 0) (void)xb_add(&bar[XB_XCNT(b.x)], 1u);
    return b;
}
__device__ __forceinline__ void xcd_barrier_complete(unsigned* bar, unsigned x, unsigned& nloc, unsigned& nx) {
    const unsigned G = gridDim.x * gridDim.y * gridDim.z;
    unsigned sum, cnt, mine, sp = 0u;
    for (;;) {
        sum = 0u; cnt = 0u; mine = 0u;
#pragma unroll
        for (unsigned j = 0; j < 16; ++j) { const unsigned c = xb_ld(&bar[XB_XCNT(j)]); sum += c; cnt += (c > 0u) ? 1u : 0u; mine = (j == x) ? c : mine; }
        if (sum == G) break;
        __builtin_amdgcn_s_sleep(1);
        if ((++sp & 255u) == 0u) { if (xb_ld(&bar[XB_TMO])) break; if (sp > XB_SPIN_CAP) { atomicAdd(&bar[XB_TMO], 1u); break; } }
    }
    nloc = mine > 0u ? mine : 1u; nx = cnt > 0u ? cnt : 1u;
}

__device__ __forceinline__ void xcd_barrier(const XcdBarrier& b) {
    asm volatile("s_waitcnt vmcnt(0)" ::: "memory");
    __syncthreads();
    if (threadIdx.x == 0) {
        unsigned* bar = b.bar;
        __builtin_amdgcn_s_waitcnt(0);
        unsigned nloc = b.st[0], nx = b.st[1];
        if (nloc == 0u) { xcd_barrier_complete(bar, b.x, nloc, nx); b.st[0] = nloc; b.st[1] = nx; }
        const unsigned old = xb_add(&bar[XB_XSUB(b.x)], 1u);
        const unsigned gen = old / nloc;
        if (old + 1u == (gen + 1u) * nloc) {
            __builtin_amdgcn_fence(__ATOMIC_RELEASE, "agent");
            asm volatile("s_waitcnt vmcnt(0)" ::: "memory");
            const unsigned og = xb_add(&bar[XB_TOP], 1u);
            const unsigned tg = og / nx;
            if (og + 1u == (tg + 1u) * nx) xb_add(&bar[XB_TOPGEN], 1u);
            else XB_SPIN(xb_ld(&bar[XB_TOPGEN]) == tg, bar);
            __builtin_amdgcn_fence(__ATOMIC_ACQUIRE, "agent");
            xb_add(&bar[XB_XGEN(b.x)], 1u);
            asm volatile("s_waitcnt vmcnt(0)" ::: "memory");
        } else {
            XB_SPIN(xb_ld(&bar[XB_XGEN(b.x)]) == gen, bar);
            __builtin_amdgcn_fence(__ATOMIC_ACQUIRE, "agent");
            asm volatile("s_waitcnt vmcnt(0)" ::: "memory");
        }
    }
    __syncthreads();
}


__device__ __forceinline__ float wave_sum_fast(float v) { const float r = allred16(v);
    return __builtin_bit_cast(float, __builtin_amdgcn_readlane(__builtin_bit_cast(int, r), 0)) + __builtin_bit_cast(float, __builtin_amdgcn_readlane(__builtin_bit_cast(int, r), 16))
         + __builtin_bit_cast(float, __builtin_amdgcn_readlane(__builtin_bit_cast(int, r), 32)) + __builtin_bit_cast(float, __builtin_amdgcn_readlane(__builtin_bit_cast(int, r), 48)); }
__device__ __forceinline__ void phase_b1c(const Args& A, int l, int gw, int NGW, int lane) {
    const bf16* proj = (const bf16*)(A.ws + WS_PROJ);
    const bf16* L = (const bf16*)(A.ws + WS_L);
    unsigned char* rwin = A.ws + WS_RWIN;
    for (int it = gw; it < (NP / 4) * 12; it += NGW) {
        const int h = it % 12, m0 = (it / 12) * 4;
        const int ch = h * 64 + lane;
        unsigned ur[4], uk[4], uv[4], vr[4], vk[4], vv[4], lw[4], la[4];
        SCHED_FENCE();
#pragma unroll
        for (int i = 0; i < 4; ++i) { const int m = m0 + i; const bf16* p = proj + (size_t)m * INC + ch;
            ur[i] = p[0]; uk[i] = p[768]; uv[i] = p[1536];
            if ((m & 2047) > 0) { vr[i] = *(p - INC); vk[i] = *(p - INC + 768); vv[i] = *(p - INC + 1536); } else { vr[i] = 0; vk[i] = 0; vv[i] = 0; }
            lw[i] = L[(size_t)m * LCOLS + ch]; la[i] = L[(size_t)m * LCOLS + 768 + ch]; }
        const float mu_r = A.in[10][l * 2560 + ch], mu_k = A.in[10][l * 2560 + 768 + ch], mu_v = A.in[10][l * 2560 + 1536 + ch];
        const float w0 = A.in[11][l * 768 + ch], a0 = A.in[13][l * 768 + ch], kkw = A.in[16][l * 768 + ch], kaw = A.in[17][l * 768 + ch];
        SCHED_FENCE();
#pragma unroll
        for (int i = 0; i < 4; ++i) { const int m = m0 + i;
            const float fr_ = bfu(ur[i]), fk_ = bfu(uk[i]), fv_ = bfu(uv[i]);
            const float xr = fr_ + (bfu(vr[i]) - fr_) * mu_r, xk = fk_ + (bfu(vk[i]) - fk_) * mu_k, xv = fv_ + (bfu(vv[i]) - fv_) * mu_v;
            const float dec = __expf(-0.6065306597f * sigm(w0 + bfu(lw[i]))); const float a = sigm(a0 + bfu(la[i]));
            const float kku = xk * kkw; const float ssq = wave_sum_fast(kku * kku); const float kk = kku * rsqrtf(fmaxf(ssq, 1e-24f));
            unsigned char* o = rwin + ((size_t)((m >> 11) * 12 + h) * 2048 + (m & 2047)) * 896;
            *(float*)(o + lane * 4) = dec;
            *(bf16*)(o + 256 + lane * 2) = f2bf(xr); *(bf16*)(o + 384 + lane * 2) = f2bf(xk * (1.f + (a - 1.f) * kaw));
            *(bf16*)(o + 512 + lane * 2) = f2bf(-kk); *(bf16*)(o + 640 + lane * 2) = f2bf(kk * a); *(bf16*)(o + 768 + lane * 2) = f2bf(xv); }
    }
}

__device__ __forceinline__ void rwkv_block_item(const Args& A, int l, LAS float* lds, int stream, int qt) {
    const int tid = tidx(), lane = tid & 63, w = __builtin_amdgcn_readfirstlane(tid >> 6), rl = lane >> 4, j = lane & 15;
    const int b = stream / 12, h = stream % 12;
    const size_t row0 = (size_t)b * 2048;
    LAS float* buf = lds;
    LAS float* ybuf = lds + 2 * 16 * 384;
    if (w < 4) {
        __builtin_amdgcn_s_setprio(2);
        f32x4 S = (f32x4){0.f, 0.f, 0.f, 0.f};
        const int vr = w * 4 + rl;
        const bool jb0 = (j & 1) != 0, jb1 = (j & 2) != 0;
        float yp[4];
        const int vrow = qt * 16 + vr;
        __syncthreads();
        for (int c = 0; c < 128; ++c) {
            const LAS float* base = buf + (c & 1) * 6144;
            LAS float* yb = ybuf + (c & 1) * 256;
            f32x4 r4 = *(const LAS f32x4*)(base + j * 4), w4 = *(const LAS f32x4*)(base + 64 + j * 4), k4 = *(const LAS f32x4*)(base + 128 + j * 4), a4 = *(const LAS f32x4*)(base + 192 + j * 4), b4 = *(const LAS f32x4*)(base + 256 + j * 4);
            float vv = base[320 + vrow];
#pragma unroll
            for (int tt = 0; tt < 16; ++tt) {
                f32x4 nr4 = r4, nw4 = w4, nk4 = k4, na4 = a4, nb4 = b4; float nvv = vv;
                if (tt < 15) { const LAS float* bs = base + (tt + 1) * 384 + j * 4;
                    nr4 = *(const LAS f32x4*)(bs); nw4 = *(const LAS f32x4*)(bs + 64); nk4 = *(const LAS f32x4*)(bs + 128); na4 = *(const LAS f32x4*)(bs + 192); nb4 = *(const LAS f32x4*)(bs + 256);
                    nvv = base[(tt + 1) * 384 + 320 + vrow]; }
                float sa = __builtin_fmaf(S[3], a4[3], __builtin_fmaf(S[2], a4[2], __builtin_fmaf(S[1], a4[1], S[0] * a4[0])));
                sa = allred16(sa);
                S = S * w4 + (b4 * sa + k4 * vv);
                yp[tt & 3] = __builtin_fmaf(S[3], r4[3], __builtin_fmaf(S[2], r4[2], __builtin_fmaf(S[1], r4[1], S[0] * r4[0])));
                if ((tt & 3) == 3) {
                    const float a0 = jb0 ? yp[1] : yp[0], b0 = jb0 ? yp[0] : yp[1], a1 = jb0 ? yp[3] : yp[2], b1 = jb0 ? yp[2] : yp[3];
                    const float r01 = a0 + dppf<0xB1>(b0), r23 = a1 + dppf<0xB1>(b1);
                    const float a2 = jb1 ? r23 : r01, b2 = jb1 ? r01 : r23;
                    float r = a2 + dppf<0x4E>(b2);
                    r += dppf<0x124>(r); r += dppf<0x128>(r);
                    yb[(tt - 3 + (j & 3)) * 16 + vr] = r;
                }
                r4 = nr4; w4 = nw4; k4 = nk4; a4 = na4; b4 = nb4; vv = nvv;
            }
            __syncthreads();
        }
        *(f32x4*)(A.out + O_PRW + ((((size_t)l * 4 + b) * 12 + h) * 64 + vrow) * 64 + j * 4) = S;
        __builtin_amdgcn_s_setprio(0);
    } else {
        const int t2 = tid - 256, st = t2 >> 4, j16 = t2 & 15;
        const unsigned char* src = A.ws + WS_RWIN + ((size_t)(b * 12 + h) * 2048) * 896 + (size_t)st * 896;
        float* yraw = (float*)(A.ws + WS_YRAW);
        f32x4 cw; u32x2 cr, ck, ca, cb, cv;
#define RW_LOAD(c) do { SCHED_FENCE(); const unsigned char* p = src + (size_t)(c) * 16 * 896; cw = *(const f32x4*)(p + j16 * 16); cr = *(const u32x2*)(p + 256 + j16 * 8); ck = *(const u32x2*)(p + 384 + j16 * 8); \
        ca = *(const u32x2*)(p + 512 + j16 * 8); cb = *(const u32x2*)(p + 640 + j16 * 8); cv = *(const u32x2*)(p + 768 + j16 * 8); SCHED_FENCE(); } while (0)
#define RW_U4(u) ((f32x4){bflo((u).x), bfhi((u).x), bflo((u).y), bfhi((u).y)})
#define RW_FIN(c) do { LAS float* o = buf + ((c) & 1) * 6144 + st * 384 + j16 * 4; *(LAS f32x4*)(o) = RW_U4(cr); *(LAS f32x4*)(o + 64) = cw; *(LAS f32x4*)(o + 128) = RW_U4(ck); \
        *(LAS f32x4*)(o + 192) = RW_U4(ca); *(LAS f32x4*)(o + 256) = RW_U4(cb); *(LAS f32x4*)(o + 320) = RW_U4(cv); } while (0)
        RW_LOAD(0); RW_FIN(0); RW_LOAD(1);
        __syncthreads();
        for (int c = 0; c < 128; ++c) {
            if (c + 1 < 128) RW_FIN(c + 1);
            if (c + 2 < 128) RW_LOAD(c + 2);
            __syncthreads();
            { const int tt = t2 >> 4, i = t2 & 15; yraw[(row0 + c * 16 + tt) * YRC + h * 64 + qt * 16 + i] = ybuf[(c & 1) * 256 + tt * 16 + i]; }
        }
#undef RW_U4
#undef RW_LOAD
#undef RW_FIN
    }
}

typedef short bf16x8v __attribute__((ext_vector_type(8)));
typedef __bf16 bf16x2n __attribute__((ext_vector_type(2)));
typedef float f32x2n __attribute__((ext_vector_type(2)));
__device__ __forceinline__ unsigned pk2n(float lo, float hi) { const f32x2n v = {lo, hi}; return __builtin_bit_cast(unsigned, __builtin_convertvector(v, bf16x2n)); }
template <int CTRL> __device__ __forceinline__ float qperm(float x) { return __builtin_bit_cast(float, __builtin_amdgcn_mov_dpp(__builtin_bit_cast(int, x), CTRL, 0xf, 0xf, true)); }
__device__ __forceinline__ void hgrn_mfma_item(const Args& A, int l, LAS unsigned char* lds, const bool samp, int b, int h) {
    const int tid = tidx(), lane = tid & 63, w = __builtin_amdgcn_readfirstlane(tid >> 6), n = lane & 15, g = lane >> 4;
    const size_t row0 = samp ? (size_t)NP + (size_t)b * 8 : (size_t)b * 2048;
    const int nch = samp ? 1 : 128, nval = samp ? 8 : 16;
    const bf16* proj = (const bf16*)(A.ws + WS_PROJ);
    float* yraw = (float*)(A.ws + WS_YRAW);
    constexpr int QS = 272, OFF_QA = 0, OFF_QM = 4352, OFF_KM = 8704, OFF_KH = 13056, OFF_VT = 17152, OFF_EB = 21248, BUFB = 21760;
    const int tq = lane & 3, ch = 16 * w + (lane >> 2);
    const int c_h = h * 128 + ch;
    const float lb = (l == 0) ? 0.f : sigm(A.in[21][768 + c_h] - A.in[21][c_h]);
    pg8::f32x4 acc[8];
#pragma unroll
    for (int kt = 0; kt < 8; ++kt) acc[kt] = (pg8::f32x4){0.f, 0.f, 0.f, 0.f};
    if (samp) {
        const float* sp = A.in[4] + (((size_t)l * 128 + b) * 6 + h) * 16384 + 16 * w + n;
        SCHED_FENCE();
#pragma unroll
        for (int kt = 0; kt < 8; ++kt)
#pragma unroll
            for (int i = 0; i < 4; ++i) acc[kt][i] = sp[(size_t)(16 * kt + 4 * g + i) * 128];
        SCHED_FENCE();
    }
    unsigned rq[4], rf[4], rv[4];
#define HM_LOAD(c) do { SCHED_FENCE(); if (4 * tq < nval) { _Pragma("unroll") for (int i = 0; i < 4; ++i) { const bf16* p = proj + (row0 + (c) * 16 + 4 * tq + i) * INC + HG_OFF + c_h; rq[i] = p[0]; rf[i] = p[768]; rv[i] = p[1536]; } } \
        else { _Pragma("unroll") for (int i = 0; i < 4; ++i) { rq[i] = 0; rf[i] = 0; rv[i] = 0; } } SCHED_FENCE(); } while (0)
#define HM_FIN(c) do { LAS unsigned char* B = lds + ((c) & 1) * BUFB; \
        float q_[4], k_[4], bl[4]; float run = 0.f; \
        _Pragma("unroll") for (int i = 0; i < 4; ++i) { const float xq = bfu(rq[i]); q_[i] = xq * sigm(xq); const float f = (4 * tq < nval) ? lb + (1.f - lb) * sigm(bfu(rf[i])) : 1.f; k_[i] = 1.f - f; run += __logf(f); bl[i] = run; } \
        const float p1 = qperm<0x90>(run), p2 = qperm<0x40>(run), p3 = qperm<0x00>(run); \
        const float off = (tq >= 1 ? p1 : 0.f) + (tq >= 2 ? p2 : 0.f) + (tq >= 3 ? p3 : 0.f); \
        const float tot = qperm<0xFF>(off + run); const float bm = qperm<0x00>(run) + qperm<0x55>(run); \
        float kh[4]; \
        _Pragma("unroll") for (int i = 0; i < 4; ++i) { const float bt = off + bl[i]; const int t = 4 * tq + i; \
            *(LAS bf16*)(B + OFF_QA + t * QS + ch * 2) = (bf16)pk2n(q_[i] * __expf(bt), 0.f); \
            *(LAS bf16*)(B + OFF_QM + t * QS + ch * 2) = (bf16)pk2n(q_[i] * __expf(bt - bm), 0.f); \
            *(LAS bf16*)(B + OFF_KM + t * QS + ch * 2) = (bf16)pk2n(k_[i] * __expf(bm - bt), 0.f); \
            kh[i] = k_[i] * __expf(tot - bt); } \
        u32x2 wk; wk.x = pk2n(kh[0], kh[1]); wk.y = pk2n(kh[2], kh[3]); *(LAS u32x2*)(B + OFF_KH + ch * 32 + tq * 8) = wk; \
        u32x2 wv; wv.x = rv[0] | (rv[1] << 16); wv.y = rv[2] | (rv[3] << 16); *(LAS u32x2*)(B + OFF_VT + ch * 32 + tq * 8) = wv; \
        if (tq == 0) *(LAS float*)(B + OFF_EB + ch * 4) = __expf(tot); } while (0)
    const unsigned char* img = hgimg_base(A, b) + (size_t)((b * 6 + h) * 128) * BUFB;
    u32x4 ci[3];
#define HC_LOAD(c) do { SCHED_FENCE(); _Pragma("unroll") for (int k = 0; k < 3; ++k) { const int idx = tid + 512 * k; if (idx < BUFB / 16) ci[k] = *(const u32x4*)(img + (size_t)(c) * BUFB + idx * 16); } SCHED_FENCE(); } while (0)
#define HC_PUT(c) do { _Pragma("unroll") for (int k = 0; k < 3; ++k) { const int idx = tid + 512 * k; if (idx < BUFB / 16) *(LAS u32x4*)(lds + ((c) & 1) * BUFB + idx * 16) = ci[k]; } } while (0)
    if (samp) { HM_LOAD(0); HM_FIN(0); } else { HC_LOAD(0); HC_PUT(0); HC_LOAD(1); }
    __syncthreads();
    for (int c = 0; c < nch; ++c) {
        const LAS unsigned char* B = lds + (c & 1) * BUFB;
        u32x2 Lqa0[4], Lqa1[4], Lk2[8]; u32x4 Lkm[4], Lqm[4]; pg8::f32x4 Leb[8];
        SCHED_FENCE();
#pragma unroll
        for (int ks = 0; ks < 4; ++ks) { Lqa0[ks] = *(const LAS u32x2*)(B + OFF_QA + n * QS + (32 * ks + 4 * g) * 2); Lqa1[ks] = *(const LAS u32x2*)(B + OFF_QA + n * QS + (32 * ks + 16 + 4 * g) * 2);
            Lkm[ks] = *(const LAS u32x4*)(B + OFF_KM + n * QS + (32 * ks + 8 * g) * 2); Lqm[ks] = *(const LAS u32x4*)(B + OFF_QM + n * QS + (32 * ks + 8 * g) * 2); }
        const u32x2 v2 = *(const LAS u32x2*)(B + OFF_VT + (16 * w + n) * 32 + g * 8);
#pragma unroll
        for (int kt = 0; kt < 8; ++kt) { Leb[kt] = *(const LAS pg8::f32x4*)(B + OFF_EB + (16 * kt + 4 * g) * 4); Lk2[kt] = *(const LAS u32x2*)(B + OFF_KH + (16 * kt + n) * 32 + g * 8); }
        SCHED_FENCE();
        pg8::f32x4 O = (pg8::f32x4){0.f, 0.f, 0.f, 0.f}, At = (pg8::f32x4){0.f, 0.f, 0.f, 0.f};
#pragma unroll
        for (int ks = 0; ks < 4; ++ks) {
            const u32x2 qa0 = Lqa0[ks], qa1 = Lqa1[ks];
            u32x4 qa; qa.x = qa0.x; qa.y = qa0.y; qa.z = qa1.x; qa.w = qa1.y;
            u32x4 sb; sb.x = pk2n(acc[2 * ks][0], acc[2 * ks][1]); sb.y = pk2n(acc[2 * ks][2], acc[2 * ks][3]); sb.z = pk2n(acc[2 * ks + 1][0], acc[2 * ks + 1][1]); sb.w = pk2n(acc[2 * ks + 1][2], acc[2 * ks + 1][3]);
            O = __builtin_amdgcn_mfma_f32_16x16x32_bf16(__builtin_bit_cast(bf16x8v, qa), __builtin_bit_cast(bf16x8v, sb), O, 0, 0, 0);
            const u32x4 km = Lkm[ks], qm = Lqm[ks];
            At = __builtin_amdgcn_mfma_f32_16x16x32_bf16(__builtin_bit_cast(bf16x8v, km), __builtin_bit_cast(bf16x8v, qm), At, 0, 0, 0);
        }
        u32x4 af; af.x = pk2n((4 * g + 0 <= n) ? At[0] : 0.f, (4 * g + 1 <= n) ? At[1] : 0.f); af.y = pk2n((4 * g + 2 <= n) ? At[2] : 0.f, (4 * g + 3 <= n) ? At[3] : 0.f); af.z = 0u; af.w = 0u;
        u32x4 vf; vf.x = v2.x; vf.y = v2.y; vf.z = 0u; vf.w = 0u;
        O = __builtin_amdgcn_mfma_f32_16x16x32_bf16(__builtin_bit_cast(bf16x8v, af), __builtin_bit_cast(bf16x8v, vf), O, 0, 0, 0);
        if (4 * g < nval) {
#pragma unroll
            for (int i = 0; i < 4; ++i) yraw[(row0 + c * 16 + 4 * g + i) * YRC + 768 + h * 128 + 16 * w + n] = O[i]; }
#pragma unroll
        for (int kt = 0; kt < 8; ++kt) {
            const pg8::f32x4 eb = Leb[kt];
            const u32x2 k2 = Lk2[kt];
            u32x4 kf; kf.x = k2.x; kf.y = k2.y; kf.z = 0u; kf.w = 0u;
            acc[kt] = __builtin_amdgcn_mfma_f32_16x16x32_bf16(__builtin_bit_cast(bf16x8v, kf), __builtin_bit_cast(bf16x8v, vf), acc[kt] * eb, 0, 0, 0);
        }
        if (c + 1 < nch) HC_PUT(c + 1);
        if (c + 2 < nch) HC_LOAD(c + 2);
        __syncthreads();
    }
#undef HC_LOAD
#undef HC_PUT
#undef HM_LOAD
#undef HM_FIN
#pragma unroll
    for (int kt = 0; kt < 8; ++kt)
#pragma unroll
        for (int i = 0; i < 4; ++i) A.out[(samp ? O_SHG + (((size_t)l * 128 + b) * 6 + h) * 16384 : O_PHG + (((size_t)l * 4 + b) * 6 + h) * 16384) + (size_t)(16 * kt + 4 * g + i) * 128 + 16 * w + n] = acc[kt][i];
}

__device__ __forceinline__ void hgrn_image_items(const Args& A, int l, LAS unsigned char* lds, int G) {
    const int tid = tidx(), lane = tid & 63, w = __builtin_amdgcn_readfirstlane(tid >> 6);
    const bf16* proj = (const bf16*)(A.ws + WS_PROJ);
    constexpr int QS = 272, OFF_QA = 0, OFF_QM = 4352, OFF_KM = 8704, OFF_KH = 13056, OFF_VT = 17152, OFF_EB = 21248, BUFB = 21760;
    const int tq = lane & 3, ch = 16 * w + (lane >> 2);
    unsigned rq[4], rf[4], rv[4];
    int it = blockIdx.x;
    if (it >= 3072) return;
#define HI_LOAD(itm) do { const int b_ = (itm) / 768, h_ = ((itm) >> 7) % 6, c_ = (itm) & 127; SCHED_FENCE(); _Pragma("unroll") for (int i = 0; i < 4; ++i) { \
        const bf16* p = proj + ((size_t)b_ * 2048 + c_ * 16 + 4 * tq + i) * INC + HG_OFF + h_ * 128 + ch; rq[i] = p[0]; rf[i] = p[768]; rv[i] = p[1536]; } SCHED_FENCE(); } while (0)
    HI_LOAD(it);
    for (; it < 3072; it += G) {
        const int b = it / 768, h = (it >> 7) % 6, c = it & 127;
        const int c_h = h * 128 + ch;
        const float lb = (l == 0) ? 0.f : sigm(A.in[21][768 + c_h] - A.in[21][c_h]);
        LAS unsigned char* B = lds;
        {
            float q_[4], k_[4], bl[4]; float run = 0.f;
#pragma unroll
            for (int i = 0; i < 4; ++i) { const float xq = bfu(rq[i]); q_[i] = xq * sigm(xq); const float f = lb + (1.f - lb) * sigm(bfu(rf[i])); k_[i] = 1.f - f; run += __logf(f); bl[i] = run; }
            const float p1 = qperm<0x90>(run), p2 = qperm<0x40>(run), p3 = qperm<0x00>(run);
            const float off = (tq >= 1 ? p1 : 0.f) + (tq >= 2 ? p2 : 0.f) + (tq >= 3 ? p3 : 0.f);
            const float tot = qperm<0xFF>(off + run); const float bm = qperm<0x00>(run) + qperm<0x55>(run);
            float kh[4];
#pragma unroll
            for (int i = 0; i < 4; ++i) { const float bt = off + bl[i]; const int t = 4 * tq + i;
                *(LAS bf16*)(B + OFF_QA + t * QS + ch * 2) = (bf16)pk2n(q_[i] * __expf(bt), 0.f);
                *(LAS bf16*)(B + OFF_QM + t * QS + ch * 2) = (bf16)pk2n(q_[i] * __expf(bt - bm), 0.f);
                *(LAS bf16*)(B + OFF_KM + t * QS + ch * 2) = (bf16)pk2n(k_[i] * __expf(bm - bt), 0.f);
                kh[i] = k_[i] * __expf(tot - bt); }
            u32x2 wk; wk.x = pk2n(kh[0], kh[1]); wk.y = pk2n(kh[2], kh[3]); *(LAS u32x2*)(B + OFF_KH + ch * 32 + tq * 8) = wk;
            u32x2 wv; wv.x = rv[0] | (rv[1] << 16); wv.y = rv[2] | (rv[3] << 16); *(LAS u32x2*)(B + OFF_VT + ch * 32 + tq * 8) = wv;
            if (tq == 0) *(LAS float*)(B + OFF_EB + ch * 4) = __expf(tot);
        }
        if (it + G < 3072) HI_LOAD(it + G);
        __syncthreads();
        unsigned char* dst = hgimg_base(A, b) + (size_t)((b * 6 + h) * 128 + c) * BUFB;
#pragma unroll
        for (int k = 0; k < 3; ++k) { const int idx = tid + 512 * k; if (idx < BUFB / 16) *(u32x4*)(dst + idx * 16) = *(const LAS u32x4*)(B + idx * 16); }
        __syncthreads();
    }
#undef HI_LOAD
}

__device__ __forceinline__ float expm1_neg(float x) { const float p = x * (1.f + x * (0.5f + x * (0.16666667f + x * (0.041666668f + x * (0.0083333338f + x * (0.0013888889f + x * 0.0001984127f)))))); return x > -0.25f ? p : __expf(x) - 1.f; }
#define LRU_AU(gr_, gi_, xc_, a_, u_) do { const float r_ = sigm((gr_) + ba), i_ = sigm((gi_) + bx); const float la_ = -8.0f * r_ * sp; a_ = __expf(la_); \
        u_ = sqrtf(fmaxf(-expm1_neg(2.0f * la_), 0.f)) * (i_ * (xc_)); } while (0)

__device__ __forceinline__ void lru_block_item(const Args& A, int l, LAS float* lds, int b, int cgp) {
    const int tid = tidx(), lane = tid & 63, w = tid >> 6;
    const int c = cgp * 64 + lane;
    const size_t row0 = (size_t)b * 2048 + (size_t)w * 256;
    const bf16* proj = (const bf16*)(A.ws + WS_PROJ); const bf16* xcb = (const bf16*)(A.ws + WS_XCB);
    const bf16* Lr = (const bf16*)(A.ws + WS_LR);
    bf16* ymix = (bf16*)(A.ws + WS_YMIX);
    const float ba = A.in[26][l * 512 + c], bx = A.in[28][l * 512 + c], sp = log1pf(__expf(-A.in[29][l * 512 + c]));
    LAS float* segA = lds; LAS float* segH = lds + 512;
    float Ap = 1.f, hh = 0.f;
    for (int t8 = 0; t8 < 32; ++t8) {
        unsigned gr[8], gi[8], xc[8];
        SCHED_FENCE();
#pragma unroll
        for (int e = 0; e < 8; ++e) { const size_t m = row0 + t8 * 8 + e; gr[e] = Lr[m * LRCOLS + c]; gi[e] = Lr[m * LRCOLS + 512 + c]; xc[e] = xcb[m * 512 + c]; }
        SCHED_FENCE();
#pragma unroll
        for (int e = 0; e < 8; ++e) { float a, u; LRU_AU(bfu(gr[e]), bfu(gi[e]), bfu(xc[e]), a, u); hh = a * hh + u; Ap *= a; }
    }
    segA[w * 64 + lane] = Ap; segH[w * 64 + lane] = hh;
    __syncthreads();
    float hc = 0.f;
    for (int s = 0; s < w; ++s) hc = segA[s * 64 + lane] * hc + segH[s * 64 + lane];
    for (int t8 = 0; t8 < 32; ++t8) {
        unsigned gr[8], gi[8], xc[8], gt[8];
        SCHED_FENCE();
#pragma unroll
        for (int e = 0; e < 8; ++e) { const size_t m = row0 + t8 * 8 + e; gr[e] = Lr[m * LRCOLS + c]; gi[e] = Lr[m * LRCOLS + 512 + c]; xc[e] = xcb[m * 512 + c]; gt[e] = proj[m * INC + LR_OFF + 512 + c]; }
        SCHED_FENCE();
#pragma unroll
        for (int e = 0; e < 8; ++e) { float a, u; LRU_AU(bfu(gr[e]), bfu(gi[e]), bfu(xc[e]), a, u); hc = a * hc + u; ymix[(row0 + t8 * 8 + e) * DM + 1536 + c] = f2bf(hc * gelu_tanh(bfu(gt[e]))); }
    }
    if (w == 7) A.out[O_PLR + ((size_t)l * 4 + b) * 512 + c] = hc;
    __syncthreads();
}

__device__ __forceinline__ void rwkv_wave_item(const Args& A, int l, LAS float* wl, int b, int h, int lane) {
    const bf16* proj = (const bf16*)(A.ws + WS_PROJ);
    const bf16* L = (const bf16*)(A.ws + WS_L);
    float* yraw = (float*)(A.ws + WS_YRAW);
    const int ch = h * 64 + lane;
    const size_t row0 = (size_t)NP + (size_t)b * 8;
    f32x2n S2[32];
    const float* sp = A.in[2] + ((((size_t)l * 128 + b) * 12 + h) * 64 + lane) * 64;
    {
        f32x4 sv[16];
        SCHED_FENCE();
#pragma unroll
        for (int q = 0; q < 16; ++q) sv[q] = *(const f32x4*)(sp + q * 4);
        SCHED_FENCE();
#pragma unroll
        for (int q = 0; q < 16; ++q) { S2[2 * q] = __builtin_shufflevector(sv[q], sv[q], 0, 1); S2[2 * q + 1] = __builtin_shufflevector(sv[q], sv[q], 2, 3); }
    }
    const float mu_r = A.in[10][l * 2560 + ch], mu_k = A.in[10][l * 2560 + 768 + ch], mu_v = A.in[10][l * 2560 + 1536 + ch];
    const float w0 = A.in[11][l * 768 + ch], a0 = A.in[13][l * 768 + ch], kkw = A.in[16][l * 768 + ch], kaw = A.in[17][l * 768 + ch];
    {
        float pr[8], pk[8], pv[8]; unsigned lw[8], la[8], ur[8], uk[8], uv[8];
        const float* sh = A.in[3] + ((size_t)l * 128 + b) * 2560;
        SCHED_FENCE();
#pragma unroll
        for (int t = 0; t < 8; ++t) { const bf16* p = proj + (row0 + t) * INC + ch; ur[t] = p[0]; uk[t] = p[768]; uv[t] = p[1536]; lw[t] = L[(row0 + t) * LCOLS + ch]; la[t] = L[(row0 + t) * LCOLS + 768 + ch]; }
        float qr = sh[ch], qk = sh[768 + ch], qv = sh[1536 + ch];
        SCHED_FENCE();
#pragma unroll
        for (int t = 0; t < 8; ++t) { pr[t] = bfu(ur[t]); pk[t] = bfu(uk[t]); pv[t] = bfu(uv[t]); }
#pragma unroll
        for (int t = 0; t < 8; ++t) {
            const float xr = pr[t] + (qr - pr[t]) * mu_r, xk = pk[t] + (qk - pk[t]) * mu_k, xv = pv[t] + (qv - pv[t]) * mu_v;
            qr = pr[t]; qk = pk[t]; qv = pv[t];
            const float dec = __expf(-0.6065306597f * sigm(w0 + bfu(lw[t]))); const float a = sigm(a0 + bfu(la[t]));
            const float kku = xk * kkw; const float ssq = wave_sum_fast(kku * kku); const float kk = kku * rsqrtf(fmaxf(ssq, 1e-24f));
            LAS float* o = wl + t * 384 + lane;
            o[0] = xr; o[64] = dec; o[128] = xk * (1.f + (a - 1.f) * kaw); o[192] = -kk; o[256] = kk * a; o[320] = xv;
        }
    }
    LDS_WAIT(); __builtin_amdgcn_wave_barrier();
    for (int t = 0; t < 8; ++t) {
        const LAS float* bs = wl + t * 384;
        const float vv = bs[320 + lane];
        f32x2n d0 = {0.f, 0.f}, d1 = {0.f, 0.f};
#pragma unroll
        for (int qb = 0; qb < 4; ++qb) {
            f32x4 a4[4];
            SCHED_FENCE();
#pragma unroll
            for (int j = 0; j < 4; ++j) a4[j] = *(const LAS f32x4*)(bs + 192 + (qb * 4 + j) * 4);
            SCHED_FENCE();
#pragma unroll
            for (int j = 0; j < 4; ++j) { const int q = qb * 4 + j; d0 = S2[2 * q] * __builtin_shufflevector(a4[j], a4[j], 0, 1) + d0; d1 = S2[2 * q + 1] * __builtin_shufflevector(a4[j], a4[j], 2, 3) + d1; }
        }
        const float sa = (d0[0] + d0[1]) + (d1[0] + d1[1]);
        const f32x2n sa2 = {sa, sa}, vv2 = {vv, vv};
        f32x2n y0 = {0.f, 0.f}, y1 = {0.f, 0.f};
#pragma unroll
        for (int qb = 0; qb < 4; ++qb) {
            f32x4 w4[4], k4[4], b4[4], r4[4];
            SCHED_FENCE();
#pragma unroll
            for (int j = 0; j < 4; ++j) { const int o = (qb * 4 + j) * 4; w4[j] = *(const LAS f32x4*)(bs + 64 + o); k4[j] = *(const LAS f32x4*)(bs + 128 + o); b4[j] = *(const LAS f32x4*)(bs + 256 + o); r4[j] = *(const LAS f32x4*)(bs + o); }
            SCHED_FENCE();
#pragma unroll
            for (int j = 0; j < 4; ++j) { const int q = qb * 4 + j;
                f32x2n tl = __builtin_shufflevector(k4[j], k4[j], 0, 1) * vv2, th = __builtin_shufflevector(k4[j], k4[j], 2, 3) * vv2;
                tl = __builtin_shufflevector(b4[j], b4[j], 0, 1) * sa2 + tl; th = __builtin_shufflevector(b4[j], b4[j], 2, 3) * sa2 + th;
                S2[2 * q] = S2[2 * q] * __builtin_shufflevector(w4[j], w4[j], 0, 1) + tl; S2[2 * q + 1] = S2[2 * q + 1] * __builtin_shufflevector(w4[j], w4[j], 2, 3) + th;
                y0 = S2[2 * q] * __builtin_shufflevector(r4[j], r4[j], 0, 1) + y0; y1 = S2[2 * q + 1] * __builtin_shufflevector(r4[j], r4[j], 2, 3) + y1; }
        }
        yraw[(row0 + t) * YRC + ch] = (y0[0] + y0[1]) + (y1[0] + y1[1]);
    }
    float* so = A.out + O_SRW + ((((size_t)l * 128 + b) * 12 + h) * 64 + lane) * 64;
#pragma unroll
    for (int q = 0; q < 16; ++q) *(f32x4*)(so + q * 4) = (f32x4){S2[2 * q][0], S2[2 * q][1], S2[2 * q + 1][0], S2[2 * q + 1][1]};
    __builtin_amdgcn_wave_barrier();
}

__device__ __forceinline__ void hgrn_wave_item(const Args& A, int l, LAS float* wl, int b, int h, int half, int lane) {
    const bf16* proj = (const bf16*)(A.ws + WS_PROJ);
    float* yraw = (float*)(A.ws + WS_YRAW);
    const size_t row0 = (size_t)NP + (size_t)b * 8;
    const int v = half * 64 + lane;
    float S[128];
    const float* sp = A.in[4] + (((size_t)l * 128 + b) * 6 + h) * 16384 + v;
    SCHED_FENCE();
#pragma unroll
    for (int k = 0; k < 128; ++k) S[k] = sp[(size_t)k * 128];
    unsigned vu[8];
#pragma unroll
    for (int t = 0; t < 8; ++t) vu[t] = proj[(row0 + t) * INC + HG_OFF + 1536 + h * 128 + v];
    SCHED_FENCE();
    float vv[8];
#pragma unroll
    for (int t = 0; t < 8; ++t) vv[t] = bfu(vu[t]);
#pragma unroll
    for (int ii = 0; ii < 2; ++ii) {
        const int c = h * 128 + lane + 64 * ii;
        const float lb = (l == 0) ? 0.f : sigm(A.in[21][768 + c] - A.in[21][c]);
        unsigned uq[8], uf[8];
        SCHED_FENCE();
#pragma unroll
        for (int t = 0; t < 8; ++t) { const bf16* p = proj + (row0 + t) * INC + HG_OFF + c; uq[t] = p[0]; uf[t] = p[768]; }
        SCHED_FENCE();
#pragma unroll
        for (int t = 0; t < 8; ++t) { const float pq = bfu(uq[t]), pf = bfu(uf[t]);
            wl[t * 256 + lane + 64 * ii] = pq * sigm(pq); wl[t * 256 + 128 + lane + 64 * ii] = lb + (1.f - lb) * sigm(pf); }
    }
    LDS_WAIT(); __builtin_amdgcn_wave_barrier();
#pragma unroll
    for (int t = 0; t < 8; ++t) {
        const LAS float* bs = wl + t * 256;
        const float x = vv[t];
        float o0 = 0.f, o1 = 0.f;
#pragma unroll
        for (int q = 0; q < 32; ++q) { const f32x4 q4 = *(const LAS f32x4*)(bs + q * 4), f4 = *(const LAS f32x4*)(bs + 128 + q * 4);
#pragma unroll
            for (int e = 0; e < 4; ++e) S[q * 4 + e] = x + f4[e] * (S[q * 4 + e] - x);
            o0 += S[q * 4] * q4[0] + S[q * 4 + 1] * q4[1]; o1 += S[q * 4 + 2] * q4[2] + S[q * 4 + 3] * q4[3]; }
        yraw[(row0 + t) * YRC + 768 + h * 128 + v] = o0 + o1;
    }
    float* so = A.out + O_SHG + (((size_t)l * 128 + b) * 6 + h) * 16384 + v;
#pragma unroll
    for (int k = 0; k < 128; ++k) so[(size_t)k * 128] = S[k];
    __builtin_amdgcn_wave_barrier();
}

__device__ __forceinline__ void lru_wave_item(const Args& A, int l, int b, int cgp, int lane) {
    const int c = cgp * 64 + lane;
    const size_t row0 = (size_t)NP + (size_t)b * 8;
    const bf16* proj = (const bf16*)(A.ws + WS_PROJ); const bf16* xcb = (const bf16*)(A.ws + WS_XCB);
    const bf16* Lr = (const bf16*)(A.ws + WS_LR);
    bf16* ymix = (bf16*)(A.ws + WS_YMIX);
    const float ba = A.in[26][l * 512 + c], bx = A.in[28][l * 512 + c], sp = log1pf(__expf(-A.in[29][l * 512 + c]));
    float hc = A.in[5][((size_t)l * 128 + b) * 512 + c];
    unsigned gr[8], gi[8], xc[8], gt[8];
    SCHED_FENCE();
#pragma unroll
    for (int e = 0; e < 8; ++e) { const size_t m = row0 + e; gr[e] = Lr[m * LRCOLS + c]; gi[e] = Lr[m * LRCOLS + 512 + c]; xc[e] = xcb[m * 512 + c]; gt[e] = proj[m * INC + LR_OFF + 512 + c]; }
    SCHED_FENCE();
#pragma unroll
    for (int e = 0; e < 8; ++e) { float a, u; LRU_AU(bfu(gr[e]), bfu(gi[e]), bfu(xc[e]), a, u); hc = a * hc + u; ymix[(row0 + e) * DM + 1536 + c] = f2bf(hc * gelu_tanh(bfu(gt[e]))); }
    A.out[O_SLR + ((size_t)l * 128 + b) * 512 + c] = hc;
}

constexpr int N_BLOCK_ITEMS = 248, N_DYN_BLOCK_ITEMS = 768, N_WAVE_ITEMS = 1536 + 1024;
__device__ __forceinline__ void phase_b2(const Args& A, int l, LAS unsigned char* lds, int G, int ctr_idx) {
    const int tid = tidx(), lane = tid & 63, wave = __builtin_amdgcn_readfirstlane(tid >> 6);
    for (int bi = blockIdx.x; bi < N_BLOCK_ITEMS; bi += G) {
        if (bi < 192) rwkv_block_item(A, l, (LAS float*)lds, (bi & 7) + 8 * (bi >> 5), (bi >> 3) & 3);
        else if (bi < 224) lru_block_item(A, l, (LAS float*)lds, (bi - 192) >> 3, (bi - 192) & 7);
        else hgrn_mfma_item(A, l, lds, false, (bi - 224) / 6, (bi - 224) % 6);
        __syncthreads();
    }
    unsigned* ctr = (unsigned*)(A.ws + WS_CTL) + 64 * ctr_idx;
    volatile LAS int* slot = (volatile LAS int*)(lds + 131072 + 320 + 64);
    LAS float* wl = (LAS float*)(lds + wave * 12288);
    for (;;) {
        int it = 0;
        if (lane == 0) it = (int)atomicAdd(ctr, 1u);
        it = __builtin_amdgcn_readfirstlane(it);
        if (it >= N_WAVE_ITEMS) break;
        if (it < 1536) rwkv_wave_item(A, l, wl, it / 12, it % 12, lane);
        else { const int r = it - 1536; lru_wave_item(A, l, r >> 3, r & 7, lane); }
    }
    for (;;) {
        __syncthreads();
        if (tid == 0) *slot = (int)atomicAdd(ctr + 16, 1u);
        __syncthreads();
        const int it = *slot;
        if (it >= N_DYN_BLOCK_ITEMS) break;
        hgrn_mfma_item(A, l, lds, true, it / 6, it % 6);
    }
}

__device__ __forceinline__ void phase_b3(const Args& A, int l, int gw, int NGW, int lane) {
    const bf16* proj = (const bf16*)(A.ws + WS_PROJ);
    const bf16* L = (const bf16*)(A.ws + WS_L);
    const float* yraw = (const float*)(A.ws + WS_YRAW);
    bf16* ymix = (bf16*)(A.ws + WS_YMIX);
    for (int idx = gw; idx < MR * 5; idx += NGW) {
        const int m = idx / 5, u = idx % 5;
        if (u < 3) {
            ROW_INFO(m)
            float P_mur[4], P_muk[4], P_muv[4], P_a0[4], P_ka[4], P_rk[4], P_lw[4], P_lb[4];
            float y[4], pr[4], pk[4], pv[4], qr[4], qk[4], qv[4]; unsigned la[4], g[4], ur[4], uk[4], uv[4], vr[4], vk[4], vv[4];
            SCHED_FENCE();
#pragma unroll
            for (int i = 0; i < 4; ++i) {
                const int ch = (u * 4 + i) * 64 + lane;
                y[i] = yraw[(size_t)m * YRC + ch];
                const bf16* p = proj + (size_t)m * INC + ch;
                ur[i] = p[0]; uk[i] = p[768]; uv[i] = p[1536];
                if (rt > 0) { vr[i] = *(p - INC); vk[i] = *(p - INC + 768); vv[i] = *(p - INC + 1536); qr[i] = 0.f; qk[i] = 0.f; qv[i] = 0.f; }
                else if (samp) { const float* sh = A.in[3] + ((size_t)l * 128 + rb) * 2560; qr[i] = sh[ch]; qk[i] = sh[768 + ch]; qv[i] = sh[1536 + ch]; vr[i] = 0; vk[i] = 0; vv[i] = 0; }
                else { qr[i] = 0.f; qk[i] = 0.f; qv[i] = 0.f; vr[i] = 0; vk[i] = 0; vv[i] = 0; }
                la[i] = L[(size_t)m * LCOLS + 768 + ch]; g[i] = L[(size_t)m * LCOLS + 1536 + ch];
                P_mur[i] = A.in[10][l * 2560 + ch]; P_muk[i] = A.in[10][l * 2560 + 768 + ch]; P_muv[i] = A.in[10][l * 2560 + 1536 + ch];
                P_a0[i] = A.in[13][l * 768 + ch]; P_ka[i] = A.in[17][l * 768 + ch]; P_rk[i] = A.in[18][l * 768 + ch]; P_lw[i] = A.in[19][l * 768 + ch]; P_lb[i] = A.in[20][l * 768 + ch];
            }
            SCHED_FENCE();
#pragma unroll
            for (int i = 0; i < 4; ++i) { pr[i] = bfu(ur[i]); pk[i] = bfu(uk[i]); pv[i] = bfu(uv[i]); if (rt > 0) { qr[i] = bfu(vr[i]); qk[i] = bfu(vk[i]); qv[i] = bfu(vv[i]); } }
#pragma unroll
            for (int i = 0; i < 4; ++i) {
                const int ch = (u * 4 + i) * 64 + lane;
                const float mean = wave_sum_fast(y[i]) * (1.f / 64.f); const float d = y[i] - mean; const float var = wave_sum_fast(d * d) * (1.f / 64.f);
                const float yn = d * rsqrtf(var + 64e-5f) * P_lw[i] + P_lb[i];
                const float xr = pr[i] + (qr[i] - pr[i]) * P_mur[i], xk = pk[i] + (qk[i] - pk[i]) * P_muk[i], xv = pv[i] + (qv[i] - pv[i]) * P_muv[i];
                const float a = sigm(P_a0[i] + bfu(la[i]));
                const float kf = xk * (1.f + (a - 1.f) * P_ka[i]);
                const float bsum = wave_sum_fast(xr * kf * P_rk[i]);
                ymix[(size_t)m * DM + ch] = f2bf((yn + bsum * xv) * bfu(g[i]));
            }
        } else {
            float o0[3], o1[3], g0[3], g1[3], n0[3], n1[3]; unsigned h0[3], h1[3];
            SCHED_FENCE();
#pragma unroll
            for (int i = 0; i < 3; ++i) {
                const int c0 = ((u - 3) * 3 + i) * 128 + lane, c1 = c0 + 64;
                o0[i] = yraw[(size_t)m * YRC + 768 + c0]; o1[i] = yraw[(size_t)m * YRC + 768 + c1];
                h0[i] = proj[(size_t)m * INC + HG_OFF + 2304 + c0]; h1[i] = proj[(size_t)m * INC + HG_OFF + 2304 + c1];
                n0[i] = A.in[22][l * 768 + c0]; n1[i] = A.in[22][l * 768 + c1];
            }
            SCHED_FENCE();
#pragma unroll
            for (int i = 0; i < 3; ++i) { g0[i] = bfu(h0[i]); g1[i] = bfu(h1[i]); }
#pragma unroll
            for (int i = 0; i < 3; ++i) {
                const int c0 = ((u - 3) * 3 + i) * 128 + lane, c1 = c0 + 64;
                const float rs = rsqrtf(wave_sum_fast(o0[i] * o0[i] + o1[i] * o1[i]) * (1.f / 128.f) + 1e-6f);
                ymix[(size_t)m * DM + 768 + c0] = f2bf(o0[i] * rs * n0[i] * (g0[i] * sigm(g0[i])));
                ymix[(size_t)m * DM + 768 + c1] = f2bf(o1[i] * rs * n1[i] * (g1[i] * sigm(g1[i])));
            }
        }
    }
}

__device__ __forceinline__ void unpack8(const u32x4 u, float (&x)[8]) { x[0] = bflo(u.x); x[1] = bfhi(u.x); x[2] = bflo(u.y); x[3] = bfhi(u.y); x[4] = bflo(u.z); x[5] = bfhi(u.z); x[6] = bflo(u.w); x[7] = bfhi(u.w); }
__device__ __forceinline__ void phase_d2(const Args& A, int l, int gt, int NGT) {
    const bf16* GV = (const bf16*)(A.ws + WS_GV);
    bf16* H = (bf16*)(A.ws + WS_H);
    for (int it = gt; it < (MR / 8) * 704; it += NGT) {
        const int chunk = it / 704, c = (it % 704) * 8;
        const int m0 = chunk * 8;
        const bool samp = m0 >= NP;
        float cw0[8], cw1[8], cw2[8], cb[8];
        {
            const float* cwp = A.in[33] + (size_t)l * 3 * FF + c; const float* cbp = A.in[34] + (size_t)l * FF + c;
#pragma unroll
            for (int h = 0; h < 2; ++h) { const f32x4 a = *(const f32x4*)(cwp + 4 * h), b = *(const f32x4*)(cwp + FF + 4 * h), d = *(const f32x4*)(cwp + 2 * FF + 4 * h), e = *(const f32x4*)(cbp + 4 * h);
#pragma unroll
                for (int q = 0; q < 4; ++q) { cw0[4 * h + q] = a[q]; cw1[4 * h + q] = b[q]; cw2[4 * h + q] = d[q]; cb[4 * h + q] = e[q]; } }
        }
        float x1[8], x2[8];
        if (!samp) {
            const int t0 = m0 & 2047;
            if (t0 > 0) { unpack8(*(const u32x4*)(GV + (size_t)(m0 - 1) * FF2 + c), x1); unpack8(*(const u32x4*)(GV + (size_t)(m0 - 2) * FF2 + c), x2); }
            else {
#pragma unroll
                for (int e = 0; e < 8; ++e) { x1[e] = 0.f; x2[e] = 0.f; } }
        }
        for (int r4 = 0; r4 < 2; ++r4) {
          u32x4 rawg[4], rawv[4];
          SCHED_FENCE();
#pragma unroll
          for (int q = 0; q < 4; ++q) { const bf16* gp = GV + (size_t)(m0 + r4 * 4 + q) * FF2 + c; rawg[q] = *(const u32x4*)gp; rawv[q] = *(const u32x4*)(gp + FF); }
          SCHED_FENCE();
#pragma unroll
          for (int q = 0; q < 4; ++q) {
            const int r = r4 * 4 + q;
            const int m = m0 + r;
            if (samp && (r & 7) == 0) {
                const int rb = (m - NP) >> 3;
                const float* s = A.in[7] + (((size_t)l * 128 + rb) * 2) * FF + c;
#pragma unroll
                for (int h = 0; h < 2; ++h) { const f32x4 a = *(const f32x4*)(s + 4 * h), b = *(const f32x4*)(s + FF + 4 * h);
#pragma unroll
                    for (int q = 0; q < 4; ++q) { x2[4 * h + q] = a[q]; x1[4 * h + q] = b[q]; } }
            }
            float x0[8], vl[8], o[8];
            unpack8(rawg[q], x0); unpack8(rawv[q], vl);
#pragma unroll
            for (int e = 0; e < 8; ++e) { const float gc = cb[e] + cw0[e] * x2[e] + cw1[e] * x1[e] + cw2[e] * x0[e]; o[e] = gc * sigm(gc) * vl[e]; }
            u32x4 w; w.x = pk2(o[0], o[1]); w.y = pk2(o[2], o[3]); w.z = pk2(o[4], o[5]); w.w = pk2(o[6], o[7]);
            *(u32x4*)(H + (size_t)m * FF + c) = w;
            const int rt = samp ? (r & 7) : (m & 2047), rT = samp ? 8 : 2048;
            if (rt >= rT - 2) {
                const int rb = samp ? (m - NP) >> 3 : m >> 11;
                float* dst = A.out + (samp ? O_SFC + (((size_t)l * 128 + rb) * 2 + (rt - (rT - 2))) * FF : O_PFC + (((size_t)l * 4 + rb) * 2 + (rt - (rT - 2))) * FF) + c;
                *(f32x4*)dst = (f32x4){x0[0], x0[1], x0[2], x0[3]}; *(f32x4*)(dst + 4) = (f32x4){x0[4], x0[5], x0[6], x0[7]};
            }
#pragma unroll
            for (int e = 0; e < 8; ++e) { x2[e] = x1[e]; x1[e] = x0[e]; }
          }
        }
    }
}

__device__ __forceinline__ void phase_final(const Args& A, int gw, int NGW, int lane) {
    float* Y = A.out + O_Y; const bf16* Xb = (const bf16*)(A.ws + WS_XB); const float* ss = (const float*)(A.ws + WS_SS) + 4 * MR;
    for (int m = gw; m < MR; m += NGW) {
        u32x2 xv[8]; f32x4 nf[8];
        SCHED_FENCE();
        const float ssm = ss[m];
#pragma unroll
        for (int i = 0; i < 8; ++i) { xv[i] = *(const u32x2*)(Xb + (size_t)m * DM + i * 256 + lane * 4); nf[i] = *(const f32x4*)(A.in[36] + i * 256 + lane * 4); }
        SCHED_FENCE();
        const float rs = rsqrtf(ssm * (1.f / 2048.f) + 1e-6f);
#pragma unroll
        for (int i = 0; i < 8; ++i) *(f32x4*)(Y + (size_t)m * DM + i * 256 + lane * 4) = (f32x4){bflo(xv[i].x), bfhi(xv[i].x), bflo(xv[i].y), bfhi(xv[i].y)} * rs * nf[i];
    }
}

#ifndef REP_GEMM
#define REP_GEMM 1
#endif
#ifndef REP_B2
#define REP_B2 1
#endif
#ifndef REP_EW
#define REP_EW 1
#endif
__global__ void __launch_bounds__(512, 2) mk_fwd(Args A) {
    extern __shared__ __attribute__((aligned(16))) unsigned char lds_raw[];
    LAS unsigned char* lds = (LAS unsigned char*)lds_raw;
    cg::grid_group grid = cg::this_grid();
    volatile LAS unsigned* MISC = (volatile LAS unsigned*)(lds + 131072 + 320);
    if (threadIdx.x < 32) MISC[threadIdx.x] = 0u;
    __syncthreads();
    XcdBarrier xbar = xcd_barrier_post((unsigned*)(A.ws + WS_XBAR), MISC + 8);
#define GSYNC() xcd_barrier(xbar)
#define IDLE_CONVERT(first256, lay, lo, hi) do { const int tid_ = tidx(), lane_ = tid_ & 63, wave_ = __builtin_amdgcn_readfirstlane(tid_ >> 6); const int first_ = (G == 256) ? (first256) : 0; \
        if (bx >= first_) convert_weights(A, lds, (bx - first_) * 8 + wave_, (G - first_) * 8, wave_, lane_, (lay), 1, (lo), (hi)); } while (0)
    const int G = gridDim.x, bx = blockIdx.x, NGW = G * 8, NGT = G * 512;
#define TID_VARS const int tid = tidx(), lane = tid & 63, wave = __builtin_amdgcn_readfirstlane(tid >> 6), gw = bx * 8 + wave, gt = bx * 512 + tid; (void)lane; (void)gw; (void)gt;
    float* const ss = (float*)(A.ws + WS_SS);
    bf16* const Xb = (bf16*)(A.ws + WS_XB);

    { TID_VARS phase_prologue(A, lds, gw, NGW, gt, NGT, wave, lane); }
    grid.sync();
    for (int l = 0; l < 2; ++l) {
        for (int rep = 0; rep < REP_GEMM; ++rep) {
            pg8::Gemm g{(const pg8::bf16_t*)(A.ws + WS_XB), (const pg8::bf16_t*)(A.ws + WS_WIN) + (size_t)l * INC * DM, MR, INC, DM};
            pg8::StaticOrder S; S.init(MR, INC, G, bx);
            EpiScaleBf16 E{(bf16*)(A.ws + WS_PROJ), INC, ss + (2 * l) * MR};
            pg8::gemm_phase<EpiScaleBf16, pg8::StaticOrder, true, true>(lds, g, S, E);
            if (l == 0 && rep == 0) IDLE_CONVERT(168, 0, 19968, 1 << 30);
            GSYNC();
        }
        for (int rep = 0; rep < REP_EW; ++rep) { TID_VARS phase_b1a(A, l, gw, NGW, lane); GSYNC(); }
        for (int rep = 0; rep < REP_GEMM; ++rep) {
            pg8::Gemm g{(const pg8::bf16_t*)(A.ws + WS_AP), (const pg8::bf16_t*)(A.ws + WS_BL) + (size_t)l * LCOLS * 256, MR, LCOLS, 256};
            pg8::StaticOrder S; S.init(MR, LCOLS, G, bx);
            EpiBf16 E{(bf16*)(A.ws + WS_L), LCOLS};
            pg8::gemm_phase<EpiBf16, pg8::StaticOrder, true, true>(lds, g, S, E);
            pg8::Gemm g2{(const pg8::bf16_t*)(A.ws + WS_XCB), (const pg8::bf16_t*)(A.ws + WS_BLRU) + (size_t)l * LRCOLS * 512, MR, LRCOLS, 512};
            pg8::StaticOrder S2; S2.init(MR, LRCOLS, G, G - 1 - bx);
            EpiBf16 E2{(bf16*)(A.ws + WS_LR), LRCOLS};
            pg8::gemm_phase<EpiBf16, pg8::StaticOrder, true, true>(lds, g2, S2, E2);
            GSYNC();
        }
        { TID_VARS phase_b1c(A, l, gw, NGW, lane); } hgrn_image_items(A, l, lds, G); GSYNC();
        for (int rep = 0; rep < REP_B2; ++rep) { phase_b2(A, l, lds, G, 1 + l + 2 * rep); GSYNC(); }
        for (int rep = 0; rep < REP_EW; ++rep) { TID_VARS phase_b3(A, l, gw, NGW, lane); GSYNC(); }
        {
            pg8::Gemm g{(const pg8::bf16_t*)(A.ws + WS_YMIX), (const pg8::bf16_t*)(A.ws + WS_WOUT) + (size_t)l * DM * DM, MR, DM, DM};
            pg8::StaticOrder S; S.init(MR, DM, G, bx);
            EpiResid E{Xb, ss + (2 * l + 1) * MR};
            pg8::gemm_phase<EpiResid, pg8::StaticOrder, true, true>(lds, g, S, E);
        }
        if (l == 0) IDLE_CONVERT(32, 0, 8704, 19968);
        GSYNC();
        for (int rep = 0; rep < REP_GEMM; ++rep) {
            pg8::Gemm g{(const pg8::bf16_t*)(A.ws + WS_XB), (const pg8::bf16_t*)(A.ws + WS_WUP) + (size_t)l * FF2 * DM, MR, FF2, DM};
            pg8::StaticOrder S; S.init(MR, FF2, G, bx);
            EpiScaleBf16 E{(bf16*)(A.ws + WS_GV), FF2, ss + (2 * l + 1) * MR};
            pg8::gemm_phase<EpiScaleBf16, pg8::StaticOrder, true, true>(lds, g, S, E);
            if (l == 0 && rep == 0) IDLE_CONVERT(48, 1, 0, 8704);
            GSYNC();
        }
        for (int rep = 0; rep < REP_EW; ++rep) { TID_VARS phase_d2(A, l, gt, NGT); GSYNC(); }
        {
            pg8::Gemm g{(const pg8::bf16_t*)(A.ws + WS_H), (const pg8::bf16_t*)(A.ws + WS_WDN) + (size_t)l * DM * FF, MR, DM, FF};
            pg8::StaticOrder S; S.init(MR, DM, G, bx);
            EpiResid E{Xb, ss + (2 * l + 2) * MR};
            pg8::gemm_phase<EpiResid, pg8::StaticOrder, true, true>(lds, g, S, E);
        }
        if (l == 0) {
            const int tid = tidx(), lane = tid & 63, wave = __builtin_amdgcn_readfirstlane(tid >> 6);
            const int first = (G == 256) ? 32 : 0;
            if (bx >= first) convert_weights(A, lds, (bx - first) * 8 + wave, (G - first) * 8, wave, lane, 1, 1, 8704, 1 << 30);
        }
        GSYNC();
    }
    { TID_VARS phase_final(A, gw, NGW, lane); }
}

extern "C" void kernel_launch(void* const* d_in, const int* in_sizes, int n_in, void* d_out, int out_size, void* d_ws, size_t ws_size, hipStream_t stream) {
    static int grid = 0;
    if (grid == 0) {
        if (n_in != 37 || (size_t)out_size != O_END || ws_size < WS_END) { fprintf(stderr, "kernel_launch: unexpected shapes: n_in %d out %d ws %zu (need %zu)\n", n_in, out_size, ws_size, (size_t)WS_END); grid = -1; return; }
        int dev = 0, cus = 0, per_cu = 0;
        if (hipGetDevice(&dev) != hipSuccess || hipDeviceGetAttribute(&cus, hipDeviceAttributeMultiprocessorCount, dev) != hipSuccess) { grid = -1; return; }
        if (hipFuncSetAttribute((const void*)mk_fwd, hipFuncAttributeMaxDynamicSharedMemorySize, LDS_BYTES) != hipSuccess) { fprintf(stderr, "kernel_launch: hipFuncSetAttribute failed\n"); grid = -1; return; }
        if (hipOccupancyMaxActiveBlocksPerMultiprocessor(&per_cu, (const void*)mk_fwd, 512, LDS_BYTES) != hipSuccess || per_cu < 1) { fprintf(stderr, "kernel_launch: occupancy query failed (%d)\n", per_cu); (void)hipGetLastError(); grid = -1; return; }
        grid = cus;
    }
    if (grid < 0) return;
    (void)hipMemsetAsync((char*)d_ws + WS_CTL, 0, CTL_ZERO_BYTES, stream);
    Args a{};
    for (int i = 0; i < 37; ++i) a.in[i] = (const float*)d_in[i];
    a.out = (float*)d_out; a.ws = (unsigned char*)d_ws;
    void* args[] = {&a};
    hipError_t e = hipLaunchCooperativeKernel((const void*)mk_fwd, dim3(grid), dim3(512), args, LDS_BYTES, stream);
    if (e != hipSuccess) fprintf(stderr, "kernel_launch: cooperative launch failed: %s (grid %d)\n", hipGetErrorString(e), grid);
}
```

```cpp
#include <hip/hip_runtime.h>
#include <hip/hip_cooperative_groups.h>
#include <cstdio>
#include <cstdint>
namespace cg = cooperative_groups;
namespace pg8 {
#define PG8_LAS __attribute__((address_space(3)))
typedef unsigned short bf16_t;
typedef short bf16x8 __attribute__((ext_vector_type(8)));
typedef float f32x4 __attribute__((ext_vector_type(4)));
typedef unsigned u32x4 __attribute__((ext_vector_type(4)));
constexpr int BM = 256, BK = 64, HALF = 128, HTB = HALF * BK * 2  , STAGE_BYTES = 8 * HTB, NXCD = 8, WGM = 8;

__host__ __device__ __forceinline__ int lds_byte(int r, int c) { const int st = (r >> 4) * 2 + (c >> 5), rr = r & 15, cc = c & 31, ob = rr * 64 + cc * 2; return st * 1024 + (ob ^ (((ob >> 9) & 1) << 5)); }
__host__ __device__ __forceinline__ void stage_rc(int b, int& R, int& C) { const int st = b / 1024, sb = b % 1024, swz = sb ^ (((sb >> 9) & 1) << 5); R = (st >> 1) * 16 + swz / 64; C = (st & 1) * 32 + (swz % 64) / 2; }
__host__ __device__ __forceinline__ int perm32(int rho) { const int n = rho >> 4, i = rho & 15; return 8 * (i >> 2) + 4 * n + (i & 3); }

struct Unit { int pm, pn; };
struct Gemm { const bf16_t* A; const bf16_t* Bt; int M, N, K; };

struct StaticOrder {
    int nM, nN, nwg, G, c;
    __host__ __device__ void init(int M, int N, int G_, int c_) { nM = M / BM; nN = N / BM; nwg = nM * nN; G = G_; c = c_; }
    __host__ __device__ bool next(int i, Unit& u) const {
        const long L = (long)i * G + c; if (L >= nwg) return false;
        int wgid = (int)L; { const int q = nwg / NXCD, r = nwg % NXCD, xcd = wgid % NXCD, off = wgid / NXCD; wgid = (xcd < r ? xcd * (q + 1) : r * (q + 1) + (xcd - r) * q) + off; }
        const int nig = WGM * nN, gid = wgid / nig, fm = gid * WGM, gsz = (nM - fm) < WGM ? (nM - fm) : WGM;
        u.pm = fm + ((wgid % nig) % gsz); u.pn = (wgid % nig) / gsz; return true;
    }
    __device__ __forceinline__ void a_ready(const Unit&) const {}
    __device__ __forceinline__ void done(const Unit&) const {}
};

__device__ __forceinline__ unsigned cvt_pk_bf16(float lo, float hi) { unsigned r; asm volatile("v_cvt_pk_bf16_f32 %0, %1, %2" : "=v"(r) : "v"(lo), "v"(hi)); return r; }
template <class Epi, class Sched, bool ALIGN_EPI = false, bool SP2 = false>
__device__ __forceinline__ void gemm_phase(PG8_LAS unsigned char* lds, const Gemm g, const Sched& S, const Epi& E) {
    int tid_l = threadIdx.x; asm volatile("" : "+v"(tid_l));
    const int tid = tid_l, wid = __builtin_amdgcn_readfirstlane(tid >> 6), lane = tid & 63, wr = wid >> 2, wc = wid & 3, fr = lane & 15, fq = lane >> 4;
    const int K = g.K, nt = K / BK;
    unsigned voffA[2], voffB[2];
#pragma unroll
    for (int i = 0; i < 2; ++i) { int R, C; stage_rc(tid * 16 + i * 8192, R, C); const int Rb = Epi::PERM ? ((R & ~31) + perm32(R & 31)) : R;
        voffA[i] = (unsigned)(R * K + C) * 2u; voffB[i] = (unsigned)(Rb * K + C) * 2u; }
    const size_t kstep = (size_t)(BK * 2);
    const size_t hstep = (size_t)HALF * K * 2;
    const size_t tstep = 2 * hstep;
    const unsigned ldsw = (unsigned)wid * 1024u;
    const int aoff = lds_byte(wr * 64 + fr, fq * 8), boff = lds_byte(wc * 32 + fr, fq * 8);
#define PG8_SA(b, h) (((b) * 2 + (h)) * HTB)
#define PG8_SB(b, h) ((4 + (b) * 2 + (h)) * HTB)
#define PG8_STAGE(bufoff, gbase, voff) do { _Pragma("unroll") for (int _i = 0; _i < 2; ++_i) \
        __builtin_amdgcn_global_load_lds((const unsigned*)((const char*)(gbase) + (voff)[_i]), (PG8_LAS unsigned*)(lds + (bufoff) + ldsw + _i * 8192), 16, 0, 0); } while (0)
#define PG8_LDA(dst, b, h) do { _Pragma("unroll") for (int m = 0; m < 4; ++m) _Pragma("unroll") for (int k = 0; k < 2; ++k) dst[m][k] = *(const PG8_LAS bf16x8*)(lds + PG8_SA(b, h) + aoff + m * 2048 + k * 1024); } while (0)
#define PG8_LDB(dst, b, h) do { _Pragma("unroll") for (int n = 0; n < 2; ++n) _Pragma("unroll") for (int k = 0; k < 2; ++k) dst[n][k] = *(const PG8_LAS bf16x8*)(lds + PG8_SB(b, h) + boff + n * 2048 + k * 1024); } while (0)
#define PG8_MMA(ai, bj, At, Bt) do { __builtin_amdgcn_s_setprio(1); _Pragma("unroll") for (int m = 0; m < 4; ++m) _Pragma("unroll") for (int n = 0; n < 2; ++n) _Pragma("unroll") for (int k = 0; k < 2; ++k) \
        acc[ai][bj][m][n] = __builtin_amdgcn_mfma_f32_16x16x32_bf16(Bt[n][k], At[m][k], acc[ai][bj][m][n], 0, 0, 0); __builtin_amdgcn_s_setprio(0); } while (0)
#define PG8_WAIT_V(n) asm volatile("s_waitcnt vmcnt(" #n ")" ::: "memory")
#define PG8_WAIT_L(n) asm volatile("s_waitcnt lgkmcnt(" #n ")" ::: "memory")
#define PG8_BAR __builtin_amdgcn_s_barrier()
#define PG8_SCHED __builtin_amdgcn_sched_barrier(0)
    Unit cur, nxt; int ui = 0;
    if (!S.next(0, cur)) return;
    f32x4 acc[2][2][4][2];
#pragma unroll
    for (int a = 0; a < 2; ++a)
#pragma unroll
        for (int b = 0; b < 2; ++b)
#pragma unroll
            for (int m = 0; m < 4; ++m)
#pragma unroll
                for (int n = 0; n < 2; ++n) acc[a][b][m][n] = (f32x4){0.f, 0.f, 0.f, 0.f};
    bf16x8 At[4][2], B0[2][2], B1[2][2];
    const char* cA = (const char*)g.A + (size_t)cur.pm * tstep; const char* cB = (const char*)g.Bt + (size_t)cur.pn * tstep;
    S.a_ready(cur);
    if constexpr (SP2) {
        PG8_STAGE(PG8_SB(0, 0), cB, voffB); PG8_STAGE(PG8_SB(0, 1), cB + hstep, voffB); PG8_STAGE(PG8_SA(0, 0), cA, voffA); PG8_STAGE(PG8_SA(0, 1), cA + hstep, voffA);
        if (wr == 1) PG8_BAR;
        PG8_WAIT_V(2); PG8_BAR;
        PG8_STAGE(PG8_SB(1, 0), cB + kstep, voffB); PG8_STAGE(PG8_SA(1, 0), cA + kstep, voffA); PG8_STAGE(PG8_SB(1, 1), cB + hstep + kstep, voffB);
        PG8_WAIT_V(6); PG8_BAR;
    } else {
        PG8_STAGE(PG8_SB(0, 0), cB, voffB); PG8_STAGE(PG8_SA(0, 0), cA, voffA); PG8_STAGE(PG8_SB(0, 1), cB + hstep, voffB); PG8_STAGE(PG8_SA(0, 1), cA + hstep, voffA);
        if (wr == 1) PG8_BAR;
        PG8_WAIT_V(4); PG8_BAR;
        PG8_STAGE(PG8_SB(1, 0), cB + kstep, voffB); PG8_STAGE(PG8_SA(1, 0), cA + kstep, voffA); PG8_STAGE(PG8_SB(1, 1), cB + hstep + kstep, voffB);
        PG8_WAIT_V(6); PG8_BAR;
    }
    for (;;) {
        const bool has_next = S.next(ui + 1, nxt);
        const char* nA = has_next ? (const char*)g.A + (size_t)nxt.pm * tstep : cA; const char* nB = has_next ? (const char*)g.Bt + (size_t)nxt.pn * tstep : cB;
        for (int t = 0; t < nt; t += 2) {
            const bool last = (t == nt - 2);
            const char* a1 = cA + (size_t)(t + 1) * kstep;
            const char* a2 = last ? nA : cA + (size_t)(t + 2) * kstep; const char* b2 = last ? nB : cB + (size_t)(t + 2) * kstep;
            const char* a3 = a2 + kstep; const char* b3 = b2 + kstep;
            if (last && has_next) S.a_ready(nxt);
            if constexpr (SP2) {
            PG8_LDB(B0, 0, 0); PG8_LDB(B1, 0, 1); PG8_SCHED; PG8_LDA(At, 0, 0); PG8_STAGE(PG8_SA(1, 1), a1 + hstep, voffA);
            PG8_WAIT_V(8); PG8_WAIT_L(0); PG8_BAR; PG8_MMA(0, 0, At, B0); PG8_MMA(0, 1, At, B1); PG8_BAR; PG8_SCHED;
            PG8_LDA(At, 0, 1); PG8_STAGE(PG8_SB(0, 0), b2, voffB); PG8_STAGE(PG8_SB(0, 1), b2 + hstep, voffB); PG8_STAGE(PG8_SA(0, 0), a2, voffA);
            PG8_WAIT_V(8); PG8_WAIT_L(0); PG8_BAR; PG8_MMA(1, 0, At, B0); PG8_MMA(1, 1, At, B1); PG8_BAR; PG8_SCHED;
            PG8_LDB(B0, 1, 0); PG8_LDB(B1, 1, 1); PG8_SCHED; PG8_LDA(At, 1, 0); PG8_STAGE(PG8_SA(0, 1), a2 + hstep, voffA);
            PG8_WAIT_V(8); PG8_WAIT_L(0); PG8_BAR; PG8_MMA(0, 0, At, B0); PG8_MMA(0, 1, At, B1); PG8_BAR; PG8_SCHED;
            PG8_LDA(At, 1, 1); PG8_STAGE(PG8_SB(1, 0), b3, voffB); PG8_STAGE(PG8_SB(1, 1), b3 + hstep, voffB); PG8_STAGE(PG8_SA(1, 0), a3, voffA);
            PG8_WAIT_V(8); PG8_WAIT_L(0); PG8_BAR; PG8_MMA(1, 0, At, B0); PG8_MMA(1, 1, At, B1); PG8_BAR; PG8_SCHED;
            } else {
            PG8_LDB(B0, 0, 0); PG8_SCHED; PG8_LDA(At, 0, 0); PG8_STAGE(PG8_SA(1, 1), a1 + hstep, voffA);
            PG8_WAIT_L(8); PG8_BAR; PG8_WAIT_L(0); PG8_MMA(0, 0, At, B0); PG8_BAR; PG8_SCHED;
            PG8_LDB(B1, 0, 1); PG8_STAGE(PG8_SB(0, 0), b2, voffB);
            PG8_BAR; PG8_WAIT_L(0); PG8_MMA(0, 1, At, B1); PG8_BAR;
            PG8_LDA(At, 0, 1); PG8_STAGE(PG8_SA(0, 0), a2, voffA);
            PG8_BAR; PG8_WAIT_L(0); PG8_MMA(1, 0, At, B0); PG8_BAR; PG8_SCHED;
            PG8_STAGE(PG8_SB(0, 1), b2 + hstep, voffB);
            PG8_WAIT_V(6); PG8_BAR; PG8_MMA(1, 1, At, B1); PG8_BAR;
            PG8_LDB(B0, 1, 0); PG8_SCHED; PG8_LDA(At, 1, 0); PG8_STAGE(PG8_SA(0, 1), a2 + hstep, voffA);
            PG8_WAIT_L(8); PG8_BAR; PG8_WAIT_L(0); PG8_MMA(0, 0, At, B0); PG8_BAR; PG8_SCHED;
            PG8_LDB(B1, 1, 1); PG8_STAGE(PG8_SB(1, 0), b3, voffB);
            PG8_BAR; PG8_WAIT_L(0); PG8_MMA(0, 1, At, B1); PG8_BAR;
            PG8_LDA(At, 1, 1); PG8_STAGE(PG8_SA(1, 0), a3, voffA);
            PG8_BAR; PG8_WAIT_L(0); PG8_MMA(1, 0, At, B0); PG8_BAR; PG8_SCHED;
            PG8_STAGE(PG8_SB(1, 1), b3 + hstep, voffB);
            PG8_WAIT_V(6); PG8_BAR; PG8_MMA(1, 1, At, B1); PG8_BAR;
            }
        }
        if constexpr (ALIGN_EPI) { if (wr == 0) PG8_BAR; }
        if constexpr (!Epi::AFTER_DRAIN) { E(acc, cur, wr, wc, fr, fq); S.done(cur); }
        if (!has_next) break;
#pragma unroll
        for (int a = 0; a < 2; ++a)
#pragma unroll
            for (int b = 0; b < 2; ++b)
#pragma unroll
                for (int m = 0; m < 4; ++m)
#pragma unroll
                    for (int n = 0; n < 2; ++n) acc[a][b][m][n] = (f32x4){0.f, 0.f, 0.f, 0.f};
        cur = nxt; cA = nA; cB = nB; ++ui;
        if constexpr (ALIGN_EPI) { if (wr == 1) PG8_BAR; }
    }
    PG8_WAIT_V(0);
    if constexpr (!ALIGN_EPI) { if (wr == 0) PG8_BAR; }
    PG8_BAR;
    if constexpr (Epi::AFTER_DRAIN) { E.fused(acc, cur, wr, wc, fr, fq, lds, wid, lane); S.done(cur); }
#undef PG8_SA
#undef PG8_SB
#undef PG8_STAGE
#undef PG8_LDA
#undef PG8_LDB
#undef PG8_MMA
#undef PG8_WAIT_V
#undef PG8_WAIT_L
#undef PG8_BAR
#undef PG8_SCHED
}
}

constexpr int DM = 2048, NP = 8192, NS = 1024, MR = NP + NS;
constexpr int INC = 6656, HG_OFF = 2560, LR_OFF = 5632;
constexpr int FF = 5632, FF2 = 11264;
constexpr int LCOLS = 2304, LRCOLS = 1024, YRC = 1536;
constexpr size_t O_Y = 0;
constexpr size_t O_PRW = (size_t)MR * DM;
constexpr size_t O_PSH = O_PRW + 2ull * 4 * 12 * 64 * 64;
constexpr size_t O_PHG = O_PSH + 2ull * 4 * 2560;
constexpr size_t O_PLR = O_PHG + 2ull * 4 * 6 * 128 * 128;
constexpr size_t O_PLC = O_PLR + 2ull * 4 * 512;
constexpr size_t O_PFC = O_PLC + 2ull * 4 * 3 * 512;
constexpr size_t O_SRW = O_PFC + 2ull * 4 * 2 * 5632;
constexpr size_t O_SSH = O_SRW + 2ull * 128 * 12 * 64 * 64;
constexpr size_t O_SHG = O_SSH + 2ull * 128 * 2560;
constexpr size_t O_SLR = O_SHG + 2ull * 128 * 6 * 128 * 128;
constexpr size_t O_SLC = O_SLR + 2ull * 128 * 512;
constexpr size_t O_SFC = O_SLC + 2ull * 128 * 3 * 512;
constexpr size_t O_END = O_SFC + 2ull * 128 * 2 * 5632;
static_assert(O_END == 61992960ull, "output size");
constexpr size_t al1m(size_t x) { return (x + 1048575ull) & ~1048575ull; }
constexpr size_t WS_CTL = 0, WS_SS = 4096, CTL_ZERO_BYTES = 262144;
constexpr size_t WS_WIN = 1048576;
constexpr size_t WS_WOUT = WS_WIN + al1m(2ull * INC * DM * 2);
constexpr size_t WS_WUP = WS_WOUT + al1m(2ull * DM * DM * 2);
constexpr size_t WS_WDN = WS_WUP + al1m(2ull * FF2 * DM * 2);
constexpr size_t WS_BL = WS_WDN + al1m(2ull * DM * FF * 2);
constexpr size_t WS_BLRU = WS_BL + al1m(2ull * LCOLS * 256 * 2);
constexpr size_t WS_XB = WS_BLRU + al1m(2ull * LRCOLS * 512 * 2);
constexpr size_t WS_YMIX = WS_XB + al1m((size_t)MR * DM * 2);
constexpr size_t WS_R1 = WS_YMIX + al1m((size_t)MR * DM * 2);
constexpr size_t WS_PROJ = WS_R1;
constexpr size_t WS_AP = WS_PROJ + al1m((size_t)MR * INC * 2);
constexpr size_t WS_XCB = WS_AP + al1m((size_t)MR * 256 * 2);
constexpr size_t WS_L = WS_XCB + al1m((size_t)MR * 512 * 2);
constexpr size_t WS_LR = WS_L + al1m((size_t)MR * LCOLS * 4);
constexpr size_t WS_YRAW = WS_LR + al1m((size_t)MR * LRCOLS * 4);
constexpr size_t WS_RWIN = WS_YRAW + al1m((size_t)MR * YRC * 4);
constexpr size_t HGIMG_HALF = (size_t)2 * 6 * 128 * 21760;
static_assert(HGIMG_HALF <= (size_t)MR * DM * 2 && HGIMG_HALF <= 2ull * INC * DM * 2, "HGRN image overlays");
static_assert(HGIMG_HALF <= (size_t)MR * DM * 4, "HGRN image half fits the y region of d_out");
constexpr size_t WS_END_A = WS_RWIN + al1m((size_t)NP * 12 * 896);
constexpr size_t WS_GV = WS_R1;
constexpr size_t WS_H = WS_GV + al1m((size_t)MR * FF2 * 2);
constexpr size_t WS_END_B = WS_H + al1m((size_t)MR * FF * 2);
constexpr size_t WS_END = WS_END_A > WS_END_B ? WS_END_A : WS_END_B;
constexpr int SS_ELEMS = 5 * MR;
constexpr size_t WS_XBAR = 196608;
static_assert(WS_SS + (size_t)SS_ELEMS * 4 <= WS_XBAR && WS_XBAR + 3456 * 4 <= CTL_ZERO_BYTES, "ctl region");

constexpr int LDS_BYTES = 147456;

#define LAS __attribute__((address_space(3)))
typedef unsigned short bf16;
typedef float f32x4 __attribute__((ext_vector_type(4)));
typedef unsigned u32x4 __attribute__((ext_vector_type(4)));
typedef unsigned u32x2 __attribute__((ext_vector_type(2)));
#define LDS_WAIT() asm volatile("s_waitcnt lgkmcnt(0)" ::: "memory")
#define SCHED_FENCE() __builtin_amdgcn_sched_barrier(0)

__device__ __forceinline__ float bf2f(bf16 v) { return __uint_as_float(((unsigned)v) << 16); }
__device__ __forceinline__ float bfu(unsigned v) { return __uint_as_float(v << 16); }
__device__ __forceinline__ float bflo(unsigned u) { return __uint_as_float(u << 16); }
__device__ __forceinline__ float bfhi(unsigned u) { return __uint_as_float(u & 0xffff0000u); }
__device__ __forceinline__ unsigned pk2(float lo, float hi) { return pg8::cvt_pk_bf16(lo, hi); }
__device__ __forceinline__ bf16 f2bf(float x) { return (bf16)(pk2(x, 0.f) & 0xffffu); }
__device__ __forceinline__ float sigm(float x) { return __builtin_amdgcn_rcpf(1.f + __expf(-x)); }
__device__ __forceinline__ float tanh_f(float x) { return 1.f - 2.f * __builtin_amdgcn_rcpf(1.f + __expf(2.f * x)); }
__device__ __forceinline__ float gelu_tanh(float x) { return x * sigm(1.5957691216f * (x + 0.044715f * x * x * x)); }
__device__ __forceinline__ float wave_sum(float v) {
#pragma unroll
    for (int o = 1; o < 64; o <<= 1) v += __shfl_xor(v, o);
    return v;
}
template <int CTRL> __device__ __forceinline__ float dppf(float x) { return __builtin_bit_cast(float, __builtin_amdgcn_mov_dpp(__builtin_bit_cast(int, x), CTRL, 0xf, 0xf, true)); }
__device__ __forceinline__ float allred16(float v) { v += dppf<0xB1>(v); v += dppf<0x4E>(v); v += dppf<0x141>(v); v += dppf<0x128>(v); return v; }

struct Args { const float* in[37]; float* out; unsigned char* ws; };
__device__ __forceinline__ unsigned char* hgimg_base(const Args& A, int b) { return b < 2 ? (unsigned char*)(A.out + O_Y) : A.ws + WS_WIN - HGIMG_HALF; }
__device__ __forceinline__ int tidx() { int t = threadIdx.x; asm volatile("" : "+v"(t)); return t; }

struct EpiScaleBf16 {
    static constexpr bool PERM = true, AFTER_DRAIN = false;
    bf16* O; int ldc; const float* ss;
    __device__ __forceinline__ void operator()(const pg8::f32x4 (&acc)[2][2][4][2], const pg8::Unit& u, int wr, int wc, int fr, int fq) const {
        const int row0 = u.pm * 256 + wr * 64 + fr, col0 = u.pn * 256 + wc * 32 + 8 * fq;
#pragma unroll
        for (int ai = 0; ai < 2; ++ai)
#pragma unroll
            for (int m = 0; m < 4; ++m) {
                const int row = row0 + ai * 128 + m * 16;
                const float rs = rsqrtf(ss[row] * (1.0f / 2048.0f) + 1e-6f);
                bf16* rowp = O + (size_t)row * ldc + col0;
#pragma unroll
                for (int bj = 0; bj < 2; ++bj) {
                    const pg8::f32x4 v0 = acc[ai][bj][m][0] * rs, v1 = acc[ai][bj][m][1] * rs;
                    u32x4 w; w.x = pk2(v0[0], v0[1]); w.y = pk2(v0[2], v0[3]); w.z = pk2(v1[0], v1[1]); w.w = pk2(v1[2], v1[3]);
                    *(u32x4*)(rowp + bj * 128) = w;
                }
            }
    }
};
struct EpiBf16 {
    static constexpr bool PERM = true, AFTER_DRAIN = false;
    bf16* O; int ldc;
    __device__ __forceinline__ void operator()(const pg8::f32x4 (&acc)[2][2][4][2], const pg8::Unit& u, int wr, int wc, int fr, int fq) const {
        const int row0 = u.pm * 256 + wr * 64 + fr, col0 = u.pn * 256 + wc * 32 + 8 * fq;
#pragma unroll
        for (int ai = 0; ai < 2; ++ai)
#pragma unroll
            for (int m = 0; m < 4; ++m) {
                bf16* rowp = O + (size_t)(row0 + ai * 128 + m * 16) * ldc + col0;
#pragma unroll
                for (int bj = 0; bj < 2; ++bj) {
                    const pg8::f32x4 v0 = acc[ai][bj][m][0], v1 = acc[ai][bj][m][1];
                    u32x4 w; w.x = pk2(v0[0], v0[1]); w.y = pk2(v0[2], v0[3]); w.z = pk2(v1[0], v1[1]); w.w = pk2(v1[2], v1[3]);
                    *(u32x4*)(rowp + bj * 128) = w;
                }
            }
    }
};
struct EpiF32 {
    static constexpr bool PERM = false, AFTER_DRAIN = false;
    float* C; int ldc;
    __device__ __forceinline__ void operator()(const pg8::f32x4 (&acc)[2][2][4][2], const pg8::Unit& u, int wr, int wc, int fr, int fq) const {
        const int row0 = u.pm * 256 + wr * 64 + fr, col0 = u.pn * 256 + wc * 32 + 4 * fq;
#pragma unroll
        for (int ai = 0; ai < 2; ++ai)
#pragma unroll
            for (int m = 0; m < 4; ++m) {
                float* rowp = C + (size_t)(row0 + ai * 128 + m * 16) * ldc + col0;
#pragma unroll
                for (int bj = 0; bj < 2; ++bj)
#pragma unroll
                    for (int n = 0; n < 2; ++n) *(pg8::f32x4*)(rowp + bj * 128 + n * 16) = acc[ai][bj][m][n];
            }
    }
};
struct EpiResid {
    static constexpr bool PERM = false, AFTER_DRAIN = false;
    bf16* Xb; float* ss;
    __device__ __forceinline__ void operator()(const pg8::f32x4 (&acc)[2][2][4][2], const pg8::Unit& u, int wr, int wc, int fr, int fq) const {
        const int row0 = u.pm * 256 + wr * 64 + fr, col0 = u.pn * 256 + wc * 32 + 4 * fq;
#pragma unroll
        for (int ai = 0; ai < 2; ++ai)
#pragma unroll
            for (int m = 0; m < 4; ++m) {
                const int row = row0 + ai * 128 + m * 16;
                bf16* bp = Xb + (size_t)row * DM + col0;
                float q = 0.f;
#pragma unroll
                for (int bj = 0; bj < 2; ++bj)
#pragma unroll
                    for (int n = 0; n < 2; ++n) {
                        const u32x2 o = *(const u32x2*)(bp + bj * 128 + n * 16);
                        pg8::f32x4 x = (pg8::f32x4){bflo(o.x), bfhi(o.x), bflo(o.y), bfhi(o.y)} + acc[ai][bj][m][n];
                        q += (x[0] * x[0] + x[1] * x[1]) + (x[2] * x[2] + x[3] * x[3]);
                        u32x2 w; w.x = pk2(x[0], x[1]); w.y = pk2(x[2], x[3]);
                        *(u32x2*)(bp + bj * 128 + n * 16) = w;
                    }
                q += __shfl_xor(q, 16); q += __shfl_xor(q, 32);
                if (fq == 0) atomicAdd(ss + row, q);
                if (m & 1) asm volatile("" ::: "memory");
            }
    }
};

__device__ __forceinline__ void p0_transpose_item(const float* W, const float* nw, int K, int N, bf16* WT, LAS float* scr, int item, int lane) {
    const int nblk = N / 32, kb = item / nblk, nb = item % nblk, k0 = 64 * kb, n0 = 32 * nb;
    const int kr = lane >> 3, nq = (lane & 7) * 4;
    f32x4 v[8]; float sc[8];
    SCHED_FENCE();
#pragma unroll
    for (int i = 0; i < 8; ++i) { v[i] = *(const f32x4*)(W + (size_t)(k0 + kr + 8 * i) * N + n0 + nq); sc[i] = nw ? nw[k0 + kr + 8 * i] : 1.f; }
    SCHED_FENCE();
#pragma unroll
    for (int i = 0; i < 8; ++i) { LAS float* d = scr + (kr + 8 * i) * 33 + nq; const f32x4 x = v[i] * sc[i]; d[0] = x[0]; d[1] = x[1]; d[2] = x[2]; d[3] = x[3]; }
    LDS_WAIT(); asm volatile("" ::: "memory");
    const int c = lane & 7;
#pragma unroll
    for (int j = 0; j < 4; ++j) { const int n = (lane >> 3) + 8 * j; const LAS float* s = scr + (8 * c) * 33 + n;
        u32x4 o; o.x = pk2(s[0 * 33], s[1 * 33]); o.y = pk2(s[2 * 33], s[3 * 33]); o.z = pk2(s[4 * 33], s[5 * 33]); o.w = pk2(s[6 * 33], s[7 * 33]);
        *(u32x4*)(WT + (size_t)(n0 + n) * K + k0 + 8 * c) = o; }
    LDS_WAIT(); asm volatile("" ::: "memory");
}

__device__ __forceinline__ void convert_weights(const Args& A, LAS unsigned char* lds, int gw, int NGW, int wave, int lane, int l_first, int n_layers_w, int r_lo = 0, int r_hi = 1 << 30) {
    LAS float* scr = (LAS float*)(lds + wave * 16384);
    constexpr int I_IN = (DM / 64) * (INC / 32), I_OUT = (DM / 64) * (DM / 32), I_UP = (DM / 64) * (FF2 / 32), I_DN = (FF / 64) * (DM / 32);
    constexpr int I_L = I_IN + I_OUT + I_UP + I_DN;
    for (int it = gw; it < n_layers_w * I_L; it += NGW) {
        const int l = l_first + it / I_L; int r = it % I_L;
        if (r < r_lo || r >= r_hi) continue;
        if (r < I_IN) { p0_transpose_item(A.in[9] + (size_t)l * DM * INC, A.in[8] + l * DM, DM, INC, (bf16*)(A.ws + WS_WIN) + (size_t)l * INC * DM, scr, r, lane); continue; } r -= I_IN;
        if (r < I_OUT) { p0_transpose_item(A.in[30] + (size_t)l * DM * DM, nullptr, DM, DM, (bf16*)(A.ws + WS_WOUT) + (size_t)l * DM * DM, scr, r, lane); continue; } r -= I_OUT;
        if (r < I_UP) { p0_transpose_item(A.in[32] + (size_t)l * DM * FF2, A.in[31] + l * DM, DM, FF2, (bf16*)(A.ws + WS_WUP) + (size_t)l * FF2 * DM, scr, r, lane); continue; } r -= I_UP;
        p0_transpose_item(A.in[35] + (size_t)l * FF * DM, nullptr, FF, DM, (bf16*)(A.ws + WS_WDN) + (size_t)l * DM * FF, scr, r, lane);
    }
}
__device__ __forceinline__ void phase_prologue(const Args& A, LAS unsigned char* lds, int gw, int NGW, int gt, int NGT, int wave, int lane) {
    convert_weights(A, lds, gw, NGW, wave, lane, 0, 1, 0, 8704);
    for (int i = gt; i < 2 * LCOLS * 32; i += NGT) {
        const int l = i / (LCOLS * 32), r = i % (LCOLS * 32), n = r >> 5, k0 = (r & 31) * 8;
        float v[8];
#pragma unroll
        for (int e = 0; e < 8; ++e) v[e] = 0.f;
        if (n < 768) { if (k0 < 64) {
#pragma unroll
            for (int e = 0; e < 8; ++e) v[e] = A.in[12][((size_t)l * 64 + k0 + e) * 768 + n]; } }
        else if (n < 1536) { if (k0 >= 64 && k0 < 128) {
#pragma unroll
            for (int e = 0; e < 8; ++e) v[e] = A.in[14][((size_t)l * 64 + k0 - 64 + e) * 768 + n - 768]; } }
        else { if (k0 >= 128) {
#pragma unroll
            for (int e = 0; e < 8; ++e) v[e] = A.in[15][((size_t)l * 128 + k0 - 128 + e) * 768 + n - 1536]; } }
        u32x4 o; o.x = pk2(v[0], v[1]); o.y = pk2(v[2], v[3]); o.z = pk2(v[4], v[5]); o.w = pk2(v[6], v[7]);
        *(u32x4*)((bf16*)(A.ws + WS_BL) + ((size_t)l * LCOLS + n) * 256 + k0) = o;
    }
    for (int i = gt; i < 2 * LRCOLS * 64; i += NGT) {
        const int l = i / (LRCOLS * 64), r = i % (LRCOLS * 64), n = r >> 6, k0 = (r & 63) * 8;
        const int hb = (n & 511) >> 6, j = n & 63;
        float v[8];
#pragma unroll
        for (int e = 0; e < 8; ++e) v[e] = 0.f;
        if ((k0 >> 6) == hb) {
            const float* Wg = (n < 512) ? A.in[25] : A.in[27];
#pragma unroll
            for (int e = 0; e < 8; ++e) v[e] = Wg[(((size_t)l * 8 + hb) * 64 + (k0 & 63) + e) * 64 + j];
        }
        u32x4 o; o.x = pk2(v[0], v[1]); o.y = pk2(v[2], v[3]); o.z = pk2(v[4], v[5]); o.w = pk2(v[6], v[7]);
        *(u32x4*)((bf16*)(A.ws + WS_BLRU) + ((size_t)l * LRCOLS + n) * 512 + k0) = o;
    }
    bf16* Xb = (bf16*)(A.ws + WS_XB); float* ss = (float*)(A.ws + WS_SS);
    for (int m = gw; m < MR; m += NGW) {
        const float* src = (m < NP) ? A.in[0] + (size_t)m * DM : A.in[1] + (size_t)(m - NP) * DM;
        float q = 0.f;
        f32x4 xs[8];
        SCHED_FENCE();
#pragma unroll
        for (int i = 0; i < 8; ++i) xs[i] = *(const f32x4*)(src + i * 256 + lane * 4);
        SCHED_FENCE();
#pragma unroll
        for (int i = 0; i < 8; ++i) {
            const f32x4 x = xs[i];
            u32x2 w; w.x = pk2(x[0], x[1]); w.y = pk2(x[2], x[3]);
            *(u32x2*)(Xb + (size_t)m * DM + i * 256 + lane * 4) = w;
            q += (x[0] * x[0] + x[1] * x[1]) + (x[2] * x[2] + x[3] * x[3]);
        }
        q = wave_sum(q);
        if (lane == 0) ss[m] = q;
    }
}

#define ROW_INFO(m) const bool samp = (m) >= NP; const int rb = samp ? ((m) - NP) >> 3 : (m) >> 11; const int rt = samp ? ((m) - NP) & 7 : (m) & 2047; const int rT = samp ? 8 : 2048;

__device__ __forceinline__ void phase_b1a(const Args& A, int l, int gw, int NGW, int lane) {
    const bf16* proj = (const bf16*)(A.ws + WS_PROJ);
    bf16* Ap = (bf16*)(A.ws + WS_AP); bf16* xcb = (bf16*)(A.ws + WS_XCB);
    const float* mu = A.in[10] + l * 2560;
    for (int m = gw; m < MR; m += NGW) {
        ROW_INFO(m)
        const bf16* pr = proj + (size_t)m * INC;
        float xcur[8];
        const int c = lane * 8;
        {
            const int cl = 2304 + lane * 4;
            u32x2 cu, pu = (u32x2){0u, 0u}; f32x4 sq = (f32x4){0.f, 0.f, 0.f, 0.f}, m4;
            u32x4 xr_[4]; f32x4 xs0[4], xs1[4], w0[4], w1[4], b0, b1;
            SCHED_FENCE();
            cu = *(const u32x2*)(pr + cl);
            if (rt > 0) pu = *(const u32x2*)(pr - INC + cl);
            else if (samp) sq = *(const f32x4*)(A.in[3] + ((size_t)l * 128 + rb) * 2560 + cl);
            m4 = *(const f32x4*)(mu + cl);
            b0 = *(const f32x4*)(A.in[24] + l * 512 + c); b1 = *(const f32x4*)(A.in[24] + l * 512 + c + 4);
#pragma unroll
            for (int j = 0; j < 4; ++j) {
                const int tt = rt - 3 + j;
                xr_[j] = (u32x4){0u, 0u, 0u, 0u}; xs0[j] = (f32x4){0.f, 0.f, 0.f, 0.f}; xs1[j] = xs0[j];
                if (tt >= 0) xr_[j] = *(const u32x4*)(pr - (size_t)(3 - j) * INC + LR_OFF + c);
                else if (samp) { const float* sp_ = A.in[6] + (((size_t)l * 128 + rb) * 3 + (tt + 3)) * 512 + c; xs0[j] = *(const f32x4*)sp_; xs1[j] = *(const f32x4*)(sp_ + 4); }
                const float* wp = A.in[23] + ((size_t)l * 4 + j) * 512 + c; w0[j] = *(const f32x4*)wp; w1[j] = *(const f32x4*)(wp + 4);
            }
            SCHED_FENCE();
            {
                float p[4] = {bflo(cu.x), bfhi(cu.x), bflo(cu.y), bfhi(cu.y)}, q[4];
                if (rt > 0) { q[0] = bflo(pu.x); q[1] = bfhi(pu.x); q[2] = bflo(pu.y); q[3] = bfhi(pu.y); }
                else { q[0] = sq[0]; q[1] = sq[1]; q[2] = sq[2]; q[3] = sq[3]; }
                float o[4];
#pragma unroll
                for (int e = 0; e < 4; ++e) { const float xs = p[e] + (q[e] - p[e]) * m4[e]; o[e] = lane < 16 ? tanh_f(xs) : (lane < 32 ? xs : sigm(xs)); }
                u32x2 w; w.x = pk2(o[0], o[1]); w.y = pk2(o[2], o[3]);
                *(u32x2*)(Ap + (size_t)m * 256 + lane * 4) = w;
            }
            float acc[8];
            acc[0] = b0[0]; acc[1] = b0[1]; acc[2] = b0[2]; acc[3] = b0[3]; acc[4] = b1[0]; acc[5] = b1[1]; acc[6] = b1[2]; acc[7] = b1[3];
#pragma unroll
            for (int j = 0; j < 4; ++j) {
                const int tt = rt - 3 + j;
                float x[8];
                if (tt >= 0) { const u32x4 u = xr_[j]; x[0] = bflo(u.x); x[1] = bfhi(u.x); x[2] = bflo(u.y); x[3] = bfhi(u.y); x[4] = bflo(u.z); x[5] = bfhi(u.z); x[6] = bflo(u.w); x[7] = bfhi(u.w); }
                else { x[0] = xs0[j][0]; x[1] = xs0[j][1]; x[2] = xs0[j][2]; x[3] = xs0[j][3]; x[4] = xs1[j][0]; x[5] = xs1[j][1]; x[6] = xs1[j][2]; x[7] = xs1[j][3]; }
                acc[0] += w0[j][0] * x[0]; acc[1] += w0[j][1] * x[1]; acc[2] += w0[j][2] * x[2]; acc[3] += w0[j][3] * x[3];
                acc[4] += w1[j][0] * x[4]; acc[5] += w1[j][1] * x[5]; acc[6] += w1[j][2] * x[6]; acc[7] += w1[j][3] * x[7];
                if (j == 3) {
#pragma unroll
                    for (int e = 0; e < 8; ++e) xcur[e] = x[e]; }
            }
            u32x4 o; o.x = pk2(acc[0], acc[1]); o.y = pk2(acc[2], acc[3]); o.z = pk2(acc[4], acc[5]); o.w = pk2(acc[6], acc[7]);
            *(u32x4*)(xcb + (size_t)m * 512 + c) = o;
            if (rt >= rT - 3) {
                float* dst = A.out + (samp ? O_SLC + (((size_t)l * 128 + rb) * 3 + (rt - (rT - 3))) * 512 : O_PLC + (((size_t)l * 4 + rb) * 3 + (rt - (rT - 3))) * 512) + c;
                *(f32x4*)dst = (f32x4){xcur[0], xcur[1], xcur[2], xcur[3]}; *(f32x4*)(dst + 4) = (f32x4){xcur[4], xcur[5], xcur[6], xcur[7]};
            }
        }
        if (rt == rT - 1) {
            float* dst = A.out + (samp ? O_SSH + ((size_t)l * 128 + rb) * 2560 : O_PSH + ((size_t)l * 4 + rb) * 2560);
#pragma unroll
            for (int i = 0; i < 10; ++i) { const int c = i * 256 + lane * 4; const u32x2 u = *(const u32x2*)(pr + c);
                *(f32x4*)(dst + c) = (f32x4){bflo(u.x), bfhi(u.x), bflo(u.y), bfhi(u.y)}; }
        }
    }
}
#define XB_TMO      128
#define XB_XCNT(j)  (256  + 64 * (j))
#define XB_XSUB(j)  (1280 + 64 * (j))
#define XB_XGEN(j)  (2304 + 64 * (j))
#define XB_TOP      3328
#define XB_TOPGEN   3392
#define XCD_BAR_WORDS 3456
#define XB_SPIN_CAP (1u << 18)

__device__ __forceinline__ unsigned xb_ld(unsigned* p)              { return __hip_atomic_load(p, __ATOMIC_RELAXED, __HIP_MEMORY_SCOPE_AGENT); }
__device__ __forceinline__ unsigned xb_add(unsigned* p, unsigned v) { return __hip_atomic_fetch_add(p, v, __ATOMIC_RELAXED, __HIP_MEMORY_SCOPE_AGENT); }
__device__ __forceinline__ unsigned xb_xcc_id() { return (unsigned)__builtin_amdgcn_s_getreg((3 << 11) | 20) & 0xFu; }
#define XB_SPIN(cond, bar) do { unsigned _sp = 0; while (cond) { __builtin_amdgcn_s_sleep(1); \
    if ((++_sp & 255u) == 0u) { if (xb_ld(&(bar)[XB_TMO])) break; if (_sp > XB_SPIN_CAP) { atomicAdd(&(bar)[XB_TMO], 1u); break; } } } } while (0)

struct XcdBarrier {
    unsigned* bar; unsigned x;
    volatile LAS unsigned* st;
};

__device__ __forceinline__ XcdBarrier xcd_barrier_post(unsigned* bar, volatile LAS unsigned* st) {
    XcdBarrier b; b.bar = bar; b.x = xb_xcc_id(); b.st = st;
    if (threadIdx.x == 0) (void)xb_add(&bar[XB_XCNT(b.x)], 1u);
    return b;
}
__device__ __forceinline__ void xcd_barrier_complete(unsigned* bar, unsigned x, unsigned& nloc, unsigned& nx) {
    const unsigned G = gridDim.x * gridDim.y * gridDim.z;
    unsigned sum, cnt, mine, sp = 0u;
    for (;;) {
        sum = 0u; cnt = 0u; mine = 0u;
#pragma unroll
        for (unsigned j = 0; j < 16; ++j) { const unsigned c = xb_ld(&bar[XB_XCNT(j)]); sum += c; cnt += (c > 0u) ? 1u : 0u; mine = (j == x) ? c : mine; }
        if (sum == G) break;
        __builtin_amdgcn_s_sleep(1);
        if ((++sp & 255u) == 0u) { if (xb_ld(&bar[XB_TMO])) break; if (sp > XB_SPIN_CAP) { atomicAdd(&bar[XB_TMO], 1u); break; } }
    }
    nloc = mine > 0u ? mine : 1u; nx = cnt > 0u ? cnt : 1u;
}

__device__ __forceinline__ void xcd_barrier(const XcdBarrier& b) {
    asm volatile("s_waitcnt vmcnt(0)" ::: "memory");
    __syncthreads();
    if (threadIdx.x == 0) {
        unsigned* bar = b.bar;
        __builtin_amdgcn_s_waitcnt(0);
        unsigned nloc = b.st[0], nx = b.st[1];
        if (nloc == 0u) { xcd_barrier_complete(bar, b.x, nloc, nx); b.st[0] = nloc; b.st[1] = nx; }
        const unsigned old = xb_add(&bar[XB_XSUB(b.x)], 1u);
        const unsigned gen = old / nloc;
        if (old + 1u == (gen + 1u) * nloc) {
            __builtin_amdgcn_fence(__ATOMIC_RELEASE, "agent");
            asm volatile("s_waitcnt vmcnt(0)" ::: "memory");
            const unsigned og = xb_add(&bar[XB_TOP], 1u);
            const unsigned tg = og / nx;
            if (og + 1u == (tg + 1u) * nx) xb_add(&bar[XB_TOPGEN], 1u);
            else XB_SPIN(xb_ld(&bar[XB_TOPGEN]) == tg, bar);
            __builtin_amdgcn_fence(__ATOMIC_ACQUIRE, "agent");
            xb_add(&bar[XB_XGEN(b.x)], 1u);
            asm volatile("s_waitcnt vmcnt(0)" ::: "memory");
        } else {
            XB_SPIN(xb_ld(&bar[XB_XGEN(b.x)]) == gen, bar);
            __builtin_amdgcn_fence(__ATOMIC_ACQUIRE, "agent");
            asm volatile("s_waitcnt vmcnt(0)" ::: "memory");
        }
    }
    __syncthreads();
}


__device__ __forceinline__ float wave_sum_fast(float v) { const float r = allred16(v);
    return __builtin_bit_cast(float, __builtin_amdgcn_readlane(__builtin_bit_cast(int, r), 0)) + __builtin_bit_cast(float, __builtin_amdgcn_readlane(__builtin_bit_cast(int, r), 16))
         + __builtin_bit_cast(float, __builtin_amdgcn_readlane(__builtin_bit_cast(int, r), 32)) + __builtin_bit_cast(float, __builtin_amdgcn_readlane(__builtin_bit_cast(int, r), 48)); }
__device__ __forceinline__ void phase_b1c(const Args& A, int l, int gw, int NGW, int lane) {
    const bf16* proj = (const bf16*)(A.ws + WS_PROJ);
    const bf16* L = (const bf16*)(A.ws + WS_L);
    unsigned char* rwin = A.ws + WS_RWIN;
    for (int it = gw; it < (NP / 4) * 12; it += NGW) {
        const int h = it % 12, m0 = (it / 12) * 4;
        const int ch = h * 64 + lane;
        unsigned ur[4], uk[4], uv[4], vr[4], vk[4], vv[4], lw[4], la[4];
        SCHED_FENCE();
#pragma unroll
        for (int i = 0; i < 4; ++i) { const int m = m0 + i; const bf16* p = proj + (size_t)m * INC + ch;
            ur[i] = p[0]; uk[i] = p[768]; uv[i] = p[1536];
            if ((m & 2047) > 0) { vr[i] = *(p - INC); vk[i] = *(p - INC + 768); vv[i] = *(p - INC + 1536); } else { vr[i] = 0; vk[i] = 0; vv[i] = 0; }
            lw[i] = L[(size_t)m * LCOLS + ch]; la[i] = L[(size_t)m * LCOLS + 768 + ch]; }
        const float mu_r = A.in[10][l * 2560 + ch], mu_k = A.in[10][l * 2560 + 768 + ch], mu_v = A.in[10][l * 2560 + 1536 + ch];
        const float w0 = A.in[11][l * 768 + ch], a0 = A.in[13][l * 768 + ch], kkw = A.in[16][l * 768 + ch], kaw = A.in[17][l * 768 + ch];
        SCHED_FENCE();
#pragma unroll
        for (int i = 0; i < 4; ++i) { const int m = m0 + i;
            const float fr_ = bfu(ur[i]), fk_ = bfu(uk[i]), fv_ = bfu(uv[i]);
            const float xr = fr_ + (bfu(vr[i]) - fr_) * mu_r, xk = fk_ + (bfu(vk[i]) - fk_) * mu_k, xv = fv_ + (bfu(vv[i]) - fv_) * mu_v;
            const float dec = __expf(-0.6065306597f * sigm(w0 + bfu(lw[i]))); const float a = sigm(a0 + bfu(la[i]));
            const float kku = xk * kkw; const float ssq = wave_sum_fast(kku * kku); const float kk = kku * rsqrtf(fmaxf(ssq, 1e-24f));
            unsigned char* o = rwin + ((size_t)((m >> 11) * 12 + h) * 2048 + (m & 2047)) * 896;
            *(float*)(o + lane * 4) = dec;
            *(bf16*)(o + 256 + lane * 2) = f2bf(xr); *(bf16*)(o + 384 + lane * 2) = f2bf(xk * (1.f + (a - 1.f) * kaw));
            *(bf16*)(o + 512 + lane * 2) = f2bf(-kk); *(bf16*)(o + 640 + lane * 2) = f2bf(kk * a); *(bf16*)(o + 768 + lane * 2) = f2bf(xv); }
    }
}

__device__ __forceinline__ void rwkv_block_item(const Args& A, int l, LAS float* lds, int stream, int qt) {
    const int tid = tidx(), lane = tid & 63, w = __builtin_amdgcn_readfirstlane(tid >> 6), rl = lane >> 4, j = lane & 15;
    const int b = stream / 12, h = stream % 12;
    const size_t row0 = (size_t)b * 2048;
    LAS float* buf = lds;
    LAS float* ybuf = lds + 2 * 16 * 384;
    if (w < 4) {
        __builtin_amdgcn_s_setprio(2);
        f32x4 S = (f32x4){0.f, 0.f, 0.f, 0.f};
        const int vr = w * 4 + rl;
        const bool jb0 = (j & 1) != 0, jb1 = (j & 2) != 0;
        float yp[4];
        const int vrow = qt * 16 + vr;
        __syncthreads();
        for (int c = 0; c < 128; ++c) {
            const LAS float* base = buf + (c & 1) * 6144;
            LAS float* yb = ybuf + (c & 1) * 256;
            f32x4 r4 = *(const LAS f32x4*)(base + j * 4), w4 = *(const LAS f32x4*)(base + 64 + j * 4), k4 = *(const LAS f32x4*)(base + 128 + j * 4), a4 = *(const LAS f32x4*)(base + 192 + j * 4), b4 = *(const LAS f32x4*)(base + 256 + j * 4);
            float vv = base[320 + vrow];
#pragma unroll
            for (int tt = 0; tt < 16; ++tt) {
                f32x4 nr4 = r4, nw4 = w4, nk4 = k4, na4 = a4, nb4 = b4; float nvv = vv;
                if (tt < 15) { const LAS float* bs = base + (tt + 1) * 384 + j * 4;
                    nr4 = *(const LAS f32x4*)(bs); nw4 = *(const LAS f32x4*)(bs + 64); nk4 = *(const LAS f32x4*)(bs + 128); na4 = *(const LAS f32x4*)(bs + 192); nb4 = *(const LAS f32x4*)(bs + 256);
                    nvv = base[(tt + 1) * 384 + 320 + vrow]; }
                float sa = __builtin_fmaf(S[3], a4[3], __builtin_fmaf(S[2], a4[2], __builtin_fmaf(S[1], a4[1], S[0] * a4[0])));
                sa = allred16(sa);
                S = S * w4 + (b4 * sa + k4 * vv);
                yp[tt & 3] = __builtin_fmaf(S[3], r4[3], __builtin_fmaf(S[2], r4[2], __builtin_fmaf(S[1], r4[1], S[0] * r4[0])));
                if ((tt & 3) == 3) {
                    const float a0 = jb0 ? yp[1] : yp[0], b0 = jb0 ? yp[0] : yp[1], a1 = jb0 ? yp[3] : yp[2], b1 = jb0 ? yp[2] : yp[3];
                    const float r01 = a0 + dppf<0xB1>(b0), r23 = a1 + dppf<0xB1>(b1);
                    const float a2 = jb1 ? r23 : r01, b2 = jb1 ? r01 : r23;
                    float r = a2 + dppf<0x4E>(b2);
                    r += dppf<0x124>(r); r += dppf<0x128>(r);
                    yb[(tt - 3 + (j & 3)) * 16 + vr] = r;
                }
                r4 = nr4; w4 = nw4; k4 = nk4; a4 = na4; b4 = nb4; vv = nvv;
            }
            __syncthreads();
        }
        *(f32x4*)(A.out + O_PRW + ((((size_t)l * 4 + b) * 12 + h) * 64 + vrow) * 64 + j * 4) = S;
        __builtin_amdgcn_s_setprio(0);
    } else {
        const int t2 = tid - 256, st = t2 >> 4, j16 = t2 & 15;
        const unsigned char* src = A.ws + WS_RWIN + ((size_t)(b * 12 + h) * 2048) * 896 + (size_t)st * 896;
        float* yraw = (float*)(A.ws + WS_YRAW);
        f32x4 cw; u32x2 cr, ck, ca, cb, cv;
#define RW_LOAD(c) do { SCHED_FENCE(); const unsigned char* p = src + (size_t)(c) * 16 * 896; cw = *(const f32x4*)(p + j16 * 16); cr = *(const u32x2*)(p + 256 + j16 * 8); ck = *(const u32x2*)(p + 384 + j16 * 8); \
        ca = *(const u32x2*)(p + 512 + j16 * 8); cb = *(const u32x2*)(p + 640 + j16 * 8); cv = *(const u32x2*)(p + 768 + j16 * 8); SCHED_FENCE(); } while (0)
#define RW_U4(u) ((f32x4){bflo((u).x), bfhi((u).x), bflo((u).y), bfhi((u).y)})
#define RW_FIN(c) do { LAS float* o = buf + ((c) & 1) * 6144 + st * 384 + j16 * 4; *(LAS f32x4*)(o) = RW_U4(cr); *(LAS f32x4*)(o + 64) = cw; *(LAS f32x4*)(o + 128) = RW_U4(ck); \
        *(LAS f32x4*)(o + 192) = RW_U4(ca); *(LAS f32x4*)(o + 256) = RW_U4(cb); *(LAS f32x4*)(o + 320) = RW_U4(cv); } while (0)
        RW_LOAD(0); RW_FIN(0); RW_LOAD(1);
        __syncthreads();
        for (int c = 0; c < 128; ++c) {
            if (c + 1 < 128) RW_FIN(c + 1);
            if (c + 2 < 128) RW_LOAD(c + 2);
            __syncthreads();
            { const int tt = t2 >> 4, i = t2 & 15; yraw[(row0 + c * 16 + tt) * YRC + h * 64 + qt * 16 + i] = ybuf[(c & 1) * 256 + tt * 16 + i]; }
        }
#undef RW_U4
#undef RW_LOAD
#undef RW_FIN
    }
}

typedef short bf16x8v __attribute__((ext_vector_type(8)));
typedef __bf16 bf16x2n __attribute__((ext_vector_type(2)));
typedef float f32x2n __attribute__((ext_vector_type(2)));
__device__ __forceinline__ unsigned pk2n(float lo, float hi) { const f32x2n v = {lo, hi}; return __builtin_bit_cast(unsigned, __builtin_convertvector(v, bf16x2n)); }
template <int CTRL> __device__ __forceinline__ float qperm(float x) { return __builtin_bit_cast(float, __builtin_amdgcn_mov_dpp(__builtin_bit_cast(int, x), CTRL, 0xf, 0xf, true)); }
__device__ __forceinline__ void hgrn_mfma_item(const Args& A, int l, LAS unsigned char* lds, const bool samp, int b, int h) {
    const int tid = tidx(), lane = tid & 63, w = __builtin_amdgcn_readfirstlane(tid >> 6), n = lane & 15, g = lane >> 4;
    const size_t row0 = samp ? (size_t)NP + (size_t)b * 8 : (size_t)b * 2048;
    const int nch = samp ? 1 : 128, nval = samp ? 8 : 16;
    const bf16* proj = (const bf16*)(A.ws + WS_PROJ);
    float* yraw = (float*)(A.ws + WS_YRAW);
    constexpr int QS = 272, OFF_QA = 0, OFF_QM = 4352, OFF_KM = 8704, OFF_KH = 13056, OFF_VT = 17152, OFF_EB = 21248, BUFB = 21760;
    const int tq = lane & 3, ch = 16 * w + (lane >> 2);
    const int c_h = h * 128 + ch;
    const float lb = (l == 0) ? 0.f : sigm(A.in[21][768 + c_h] - A.in[21][c_h]);
    pg8::f32x4 acc[8];
#pragma unroll
    for (int kt = 0; kt < 8; ++kt) acc[kt] = (pg8::f32x4){0.f, 0.f, 0.f, 0.f};
    if (samp) {
        const float* sp = A.in[4] + (((size_t)l * 128 + b) * 6 + h) * 16384 + 16 * w + n;
        SCHED_FENCE();
#pragma unroll
        for (int kt = 0; kt < 8; ++kt)
#pragma unroll
            for (int i = 0; i < 4; ++i) acc[kt][i] = sp[(size_t)(16 * kt + 4 * g + i) * 128];
        SCHED_FENCE();
    }
    unsigned rq[4], rf[4], rv[4];
#define HM_LOAD(c) do { SCHED_FENCE(); if (4 * tq < nval) { _Pragma("unroll") for (int i = 0; i < 4; ++i) { const bf16* p = proj + (row0 + (c) * 16 + 4 * tq + i) * INC + HG_OFF + c_h; rq[i] = p[0]; rf[i] = p[768]; rv[i] = p[1536]; } } \
        else { _Pragma("unroll") for (int i = 0; i < 4; ++i) { rq[i] = 0; rf[i] = 0; rv[i] = 0; } } SCHED_FENCE(); } while (0)
#define HM_FIN(c) do { LAS unsigned char* B = lds + ((c) & 1) * BUFB; \
        float q_[4], k_[4], bl[4]; float run = 0.f; \
        _Pragma("unroll") for (int i = 0; i < 4; ++i) { const float xq = bfu(rq[i]); q_[i] = xq * sigm(xq); const float f = (4 * tq < nval) ? lb + (1.f - lb) * sigm(bfu(rf[i])) : 1.f; k_[i] = 1.f - f; run += __logf(f); bl[i] = run; } \
        const float p1 = qperm<0x90>(run), p2 = qperm<0x40>(run), p3 = qperm<0x00>(run); \
        const float off = (tq >= 1 ? p1 : 0.f) + (tq >= 2 ? p2 : 0.f) + (tq >= 3 ? p3 : 0.f); \
        const float tot = qperm<0xFF>(off + run); const float bm = qperm<0x00>(run) + qperm<0x55>(run); \
        float kh[4]; \
        _Pragma("unroll") for (int i = 0; i < 4; ++i) { const float bt = off + bl[i]; const int t = 4 * tq + i; \
            *(LAS bf16*)(B + OFF_QA + t * QS + ch * 2) = (bf16)pk2n(q_[i] * __expf(bt), 0.f); \
            *(LAS bf16*)(B + OFF_QM + t * QS + ch * 2) = (bf16)pk2n(q_[i] * __expf(bt - bm), 0.f); \
            *(LAS bf16*)(B + OFF_KM + t * QS + ch * 2) = (bf16)pk2n(k_[i] * __expf(bm - bt), 0.f); \
            kh[i] = k_[i] * __expf(tot - bt); } \
        u32x2 wk; wk.x = pk2n(kh[0], kh[1]); wk.y = pk2n(kh[2], kh[3]); *(LAS u32x2*)(B + OFF_KH + ch * 32 + tq * 8) = wk; \
        u32x2 wv; wv.x = rv[0] | (rv[1] << 16); wv.y = rv[2] | (rv[3] << 16); *(LAS u32x2*)(B + OFF_VT + ch * 32 + tq * 8) = wv; \
        if (tq == 0) *(LAS float*)(B + OFF_EB + ch * 4) = __expf(tot); } while (0)
    const unsigned char* img = hgimg_base(A, b) + (size_t)((b * 6 + h) * 128) * BUFB;
    u32x4 ci[3];
#define HC_LOAD(c) do { SCHED_FENCE(); _Pragma("unroll") for (int k = 0; k < 3; ++k) { const int idx = tid + 512 * k; if (idx < BUFB / 16) ci[k] = *(const u32x4*)(img + (size_t)(c) * BUFB + idx * 16); } SCHED_FENCE(); } while (0)
#define HC_PUT(c) do { _Pragma("unroll") for (int k = 0; k < 3; ++k) { const int idx = tid + 512 * k; if (idx < BUFB / 16) *(LAS u32x4*)(lds + ((c) & 1) * BUFB + idx * 16) = ci[k]; } } while (0)
    if (samp) { HM_LOAD(0); HM_FIN(0); } else { HC_LOAD(0); HC_PUT(0); HC_LOAD(1); }
    __syncthreads();
    for (int c = 0; c < nch; ++c) {
        const LAS unsigned char* B = lds + (c & 1) * BUFB;
        u32x2 Lqa0[4], Lqa1[4], Lk2[8]; u32x4 Lkm[4], Lqm[4]; pg8::f32x4 Leb[8];
        SCHED_FENCE();
#pragma unroll
        for (int ks = 0; ks < 4; ++ks) { Lqa0[ks] = *(const LAS u32x2*)(B + OFF_QA + n * QS + (32 * ks + 4 * g) * 2); Lqa1[ks] = *(const LAS u32x2*)(B + OFF_QA + n * QS + (32 * ks + 16 + 4 * g) * 2);
            Lkm[ks] = *(const LAS u32x4*)(B + OFF_KM + n * QS + (32 * ks + 8 * g) * 2); Lqm[ks] = *(const LAS u32x4*)(B + OFF_QM + n * QS + (32 * ks + 8 * g) * 2); }
        const u32x2 v2 = *(const LAS u32x2*)(B + OFF_VT + (16 * w + n) * 32 + g * 8);
#pragma unroll
        for (int kt = 0; kt < 8; ++kt) { Leb[kt] = *(const LAS pg8::f32x4*)(B + OFF_EB + (16 * kt + 4 * g) * 4); Lk2[kt] = *(const LAS u32x2*)(B + OFF_KH + (16 * kt + n) * 32 + g * 8); }
        SCHED_FENCE();
        pg8::f32x4 O = (pg8::f32x4){0.f, 0.f, 0.f, 0.f}, At = (pg8::f32x4){0.f, 0.f, 0.f, 0.f};
#pragma unroll
        for (int ks = 0; ks < 4; ++ks) {
            const u32x2 qa0 = Lqa0[ks], qa1 = Lqa1[ks];
            u32x4 qa; qa.x = qa0.x; qa.y = qa0.y; qa.z = qa1.x; qa.w = qa1.y;
            u32x4 sb; sb.x = pk2n(acc[2 * ks][0], acc[2 * ks][1]); sb.y = pk2n(acc[2 * ks][2], acc[2 * ks][3]); sb.z = pk2n(acc[2 * ks + 1][0], acc[2 * ks + 1][1]); sb.w = pk2n(acc[2 * ks + 1][2], acc[2 * ks + 1][3]);
            O = __builtin_amdgcn_mfma_f32_16x16x32_bf16(__builtin_bit_cast(bf16x8v, qa), __builtin_bit_cast(bf16x8v, sb), O, 0, 0, 0);
            const u32x4 km = Lkm[ks], qm = Lqm[ks];
            At = __builtin_amdgcn_mfma_f32_16x16x32_bf16(__builtin_bit_cast(bf16x8v, km), __builtin_bit_cast(bf16x8v, qm), At, 0, 0, 0);
        }
        u32x4 af; af.x = pk2n((4 * g + 0 <= n) ? At[0] : 0.f, (4 * g + 1 <= n) ? At[1] : 0.f); af.y = pk2n((4 * g + 2 <= n) ? At[2] : 0.f, (4 * g + 3 <= n) ? At[3] : 0.f); af.z = 0u; af.w = 0u;
        u32x4 vf; vf.x = v2.x; vf.y = v2.y; vf.z = 0u; vf.w = 0u;
        O = __builtin_amdgcn_mfma_f32_16x16x32_bf16(__builtin_bit_cast(bf16x8v, af), __builtin_bit_cast(bf16x8v, vf), O, 0, 0, 0);
        if (4 * g < nval) {
#pragma unroll
            for (int i = 0; i < 4; ++i) yraw[(row0 + c * 16 + 4 * g + i) * YRC + 768 + h * 128 + 16 * w + n] = O[i]; }
#pragma unroll
        for (int kt = 0; kt < 8; ++kt) {
            const pg8::f32x4 eb = Leb[kt];
            const u32x2 k2 = Lk2[kt];
            u32x4 kf; kf.x = k2.x; kf.y = k2.y; kf.z = 0u; kf.w = 0u;
            acc[kt] = __builtin_amdgcn_mfma_f32_16x16x32_bf16(__builtin_bit_cast(bf16x8v, kf), __builtin_bit_cast(bf16x8v, vf), acc[kt] * eb, 0, 0, 0);
        }
        if (c + 1 < nch) HC_PUT(c + 1);
        if (c + 2 < nch) HC_LOAD(c + 2);
        __syncthreads();
    }
#undef HC_LOAD
#undef HC_PUT
#undef HM_LOAD
#undef HM_FIN
#pragma unroll
    for (int kt = 0; kt < 8; ++kt)
#pragma unroll
        for (int i = 0; i < 4; ++i) A.out[(samp ? O_SHG + (((size_t)l * 128 + b) * 6 + h) * 16384 : O_PHG + (((size_t)l * 4 + b) * 6 + h) * 16384) + (size_t)(16 * kt + 4 * g + i) * 128 + 16 * w + n] = acc[kt][i];
}

__device__ __forceinline__ void hgrn_image_items(const Args& A, int l, LAS unsigned char* lds, int G) {
    const int tid = tidx(), lane = tid & 63, w = __builtin_amdgcn_readfirstlane(tid >> 6);
    const bf16* proj = (const bf16*)(A.ws + WS_PROJ);
    constexpr int QS = 272, OFF_QA = 0, OFF_QM = 4352, OFF_KM = 8704, OFF_KH = 13056, OFF_VT = 17152, OFF_EB = 21248, BUFB = 21760;
    const int tq = lane & 3, ch = 16 * w + (lane >> 2);
    unsigned rq[4], rf[4], rv[4];
    int it = blockIdx.x;
    if (it >= 3072) return;
#define HI_LOAD(itm) do { const int b_ = (itm) / 768, h_ = ((itm) >> 7) % 6, c_ = (itm) & 127; SCHED_FENCE(); _Pragma("unroll") for (int i = 0; i < 4; ++i) { \
        const bf16* p = proj + ((size_t)b_ * 2048 + c_ * 16 + 4 * tq + i) * INC + HG_OFF + h_ * 128 + ch; rq[i] = p[0]; rf[i] = p[768]; rv[i] = p[1536]; } SCHED_FENCE(); } while (0)
    HI_LOAD(it);
    for (; it < 3072; it += G) {
        const int b = it / 768, h = (it >> 7) % 6, c = it & 127;
        const int c_h = h * 128 + ch;
        const float lb = (l == 0) ? 0.f : sigm(A.in[21][768 + c_h] - A.in[21][c_h]);
        LAS unsigned char* B = lds;
        {
            float q_[4], k_[4], bl[4]; float run = 0.f;
#pragma unroll
            for (int i = 0; i < 4; ++i) { const float xq = bfu(rq[i]); q_[i] = xq * sigm(xq); const float f = lb + (1.f - lb) * sigm(bfu(rf[i])); k_[i] = 1.f - f; run += __logf(f); bl[i] = run; }
            const float p1 = qperm<0x90>(run), p2 = qperm<0x40>(run), p3 = qperm<0x00>(run);
            const float off = (tq >= 1 ? p1 : 0.f) + (tq >= 2 ? p2 : 0.f) + (tq >= 3 ? p3 : 0.f);
            const float tot = qperm<0xFF>(off + run); const float bm = qperm<0x00>(run) + qperm<0x55>(run);
            float kh[4];
#pragma unroll
            for (int i = 0; i < 4; ++i) { const float bt = off + bl[i]; const int t = 4 * tq + i;
                *(LAS bf16*)(B + OFF_QA + t * QS + ch * 2) = (bf16)pk2n(q_[i] * __expf(bt), 0.f);
                *(LAS bf16*)(B + OFF_QM + t * QS + ch * 2) = (bf16)pk2n(q_[i] * __expf(bt - bm), 0.f);
                *(LAS bf16*)(B + OFF_KM + t * QS + ch * 2) = (bf16)pk2n(k_[i] * __expf(bm - bt), 0.f);
                kh[i] = k_[i] * __expf(tot - bt); }
            u32x2 wk; wk.x = pk2n(kh[0], kh[1]); wk.y = pk2n(kh[2], kh[3]); *(LAS u32x2*)(B + OFF_KH + ch * 32 + tq * 8) = wk;
            u32x2 wv; wv.x = rv[0] | (rv[1] << 16); wv.y = rv[2] | (rv[3] << 16); *(LAS u32x2*)(B + OFF_VT + ch * 32 + tq * 8) = wv;
            if (tq == 0) *(LAS float*)(B + OFF_EB + ch * 4) = __expf(tot);
        }
        if (it + G < 3072) HI_LOAD(it + G);
        __syncthreads();
        unsigned char* dst = hgimg_base(A, b) + (size_t)((b * 6 + h) * 128 + c) * BUFB;
#pragma unroll
        for (int k = 0; k < 3; ++k) { const int idx = tid + 512 * k; if (idx < BUFB / 16) *(u32x4*)(dst + idx * 16) = *(const LAS u32x4*)(B + idx * 16); }
        __syncthreads();
    }
#undef HI_LOAD
}

__device__ __forceinline__ float expm1_neg(float x) { const float p = x * (1.f + x * (0.5f + x * (0.16666667f + x * (0.041666668f + x * (0.0083333338f + x * (0.0013888889f + x * 0.0001984127f)))))); return x > -0.25f ? p : __expf(x) - 1.f; }
#define LRU_AU(gr_, gi_, xc_, a_, u_) do { const float r_ = sigm((gr_) + ba), i_ = sigm((gi_) + bx); const float la_ = -8.0f * r_ * sp; a_ = __expf(la_); \
        u_ = sqrtf(fmaxf(-expm1_neg(2.0f * la_), 0.f)) * (i_ * (xc_)); } while (0)

__device__ __forceinline__ void lru_block_item(const Args& A, int l, LAS float* lds, int b, int cgp) {
    const int tid = tidx(), lane = tid & 63, w = tid >> 6;
    const int c = cgp * 64 + lane;
    const size_t row0 = (size_t)b * 2048 + (size_t)w * 256;
    const bf16* proj = (const bf16*)(A.ws + WS_PROJ); const bf16* xcb = (const bf16*)(A.ws + WS_XCB);
    const bf16* Lr = (const bf16*)(A.ws + WS_LR);
    bf16* ymix = (bf16*)(A.ws + WS_YMIX);
    const float ba = A.in[26][l * 512 + c], bx = A.in[28][l * 512 + c], sp = log1pf(__expf(-A.in[29][l * 512 + c]));
    LAS float* segA = lds; LAS float* segH = lds + 512;
    float Ap = 1.f, hh = 0.f;
    for (int t8 = 0; t8 < 32; ++t8) {
        unsigned gr[8], gi[8], xc[8];
        SCHED_FENCE();
#pragma unroll
        for (int e = 0; e < 8; ++e) { const size_t m = row0 + t8 * 8 + e; gr[e] = Lr[m * LRCOLS + c]; gi[e] = Lr[m * LRCOLS + 512 + c]; xc[e] = xcb[m * 512 + c]; }
        SCHED_FENCE();
#pragma unroll
        for (int e = 0; e < 8; ++e) { float a, u; LRU_AU(bfu(gr[e]), bfu(gi[e]), bfu(xc[e]), a, u); hh = a * hh + u; Ap *= a; }
    }
    segA[w * 64 + lane] = Ap; segH[w * 64 + lane] = hh;
    __syncthreads();
    float hc = 0.f;
    for (int s = 0; s < w; ++s) hc = segA[s * 64 + lane] * hc + segH[s * 64 + lane];
    for (int t8 = 0; t8 < 32; ++t8) {
        unsigned gr[8], gi[8], xc[8], gt[8];
        SCHED_FENCE();
#pragma unroll
        for (int e = 0; e < 8; ++e) { const size_t m = row0 + t8 * 8 + e; gr[e] = Lr[m * LRCOLS + c]; gi[e] = Lr[m * LRCOLS + 512 + c]; xc[e] = xcb[m * 512 + c]; gt[e] = proj[m * INC + LR_OFF + 512 + c]; }
        SCHED_FENCE();
#pragma unroll
        for (int e = 0; e < 8; ++e) { float a, u; LRU_AU(bfu(gr[e]), bfu(gi[e]), bfu(xc[e]), a, u); hc = a * hc + u; ymix[(row0 + t8 * 8 + e) * DM + 1536 + c] = f2bf(hc * gelu_tanh(bfu(gt[e]))); }
    }
    if (w == 7) A.out[O_PLR + ((size_t)l * 4 + b) * 512 + c] = hc;
    __syncthreads();
}

__device__ __forceinline__ void rwkv_wave_item(const Args& A, int l, LAS float* wl, int b, int h, int lane) {
    const bf16* proj = (const bf16*)(A.ws + WS_PROJ);
    const bf16* L = (const bf16*)(A.ws + WS_L);
    float* yraw = (float*)(A.ws + WS_YRAW);
    const int ch = h * 64 + lane;
    const size_t row0 = (size_t)NP + (size_t)b * 8;
    f32x2n S2[32];
    const float* sp = A.in[2] + ((((size_t)l * 128 + b) * 12 + h) * 64 + lane) * 64;
    {
        f32x4 sv[16];
        SCHED_FENCE();
#pragma unroll
        for (int q = 0; q < 16; ++q) sv[q] = *(const f32x4*)(sp + q * 4);
        SCHED_FENCE();
#pragma unroll
        for (int q = 0; q < 16; ++q) { S2[2 * q] = __builtin_shufflevector(sv[q], sv[q], 0, 1); S2[2 * q + 1] = __builtin_shufflevector(sv[q], sv[q], 2, 3); }
    }
    const float mu_r = A.in[10][l * 2560 + ch], mu_k = A.in[10][l * 2560 + 768 + ch], mu_v = A.in[10][l * 2560 + 1536 + ch];
    const float w0 = A.in[11][l * 768 + ch], a0 = A.in[13][l * 768 + ch], kkw = A.in[16][l * 768 + ch], kaw = A.in[17][l * 768 + ch];
    {
        float pr[8], pk[8], pv[8]; unsigned lw[8], la[8], ur[8], uk[8], uv[8];
        const float* sh = A.in[3] + ((size_t)l * 128 + b) * 2560;
        SCHED_FENCE();
#pragma unroll
        for (int t = 0; t < 8; ++t) { const bf16* p = proj + (row0 + t) * INC + ch; ur[t] = p[0]; uk[t] = p[768]; uv[t] = p[1536]; lw[t] = L[(row0 + t) * LCOLS + ch]; la[t] = L[(row0 + t) * LCOLS + 768 + ch]; }
        float qr = sh[ch], qk = sh[768 + ch], qv = sh[1536 + ch];
        SCHED_FENCE();
#pragma unroll
        for (int t = 0; t < 8; ++t) { pr[t] = bfu(ur[t]); pk[t] = bfu(uk[t]); pv[t] = bfu(uv[t]); }
#pragma unroll
        for (int t = 0; t < 8; ++t) {
            const float xr = pr[t] + (qr - pr[t]) * mu_r, xk = pk[t] + (qk - pk[t]) * mu_k, xv = pv[t] + (qv - pv[t]) * mu_v;
            qr = pr[t]; qk = pk[t]; qv = pv[t];
            const float dec = __expf(-0.6065306597f * sigm(w0 + bfu(lw[t]))); const float a = sigm(a0 + bfu(la[t]));
            const float kku = xk * kkw; const float ssq = wave_sum_fast(kku * kku); const float kk = kku * rsqrtf(fmaxf(ssq, 1e-24f));
            LAS float* o = wl + t * 384 + lane;
            o[0] = xr; o[64] = dec; o[128] = xk * (1.f + (a - 1.f) * kaw); o[192] = -kk; o[256] = kk * a; o[320] = xv;
        }
    }
    LDS_WAIT(); __builtin_amdgcn_wave_barrier();
    for (int t = 0; t < 8; ++t) {
        const LAS float* bs = wl + t * 384;
        const float vv = bs[320 + lane];
        f32x2n d0 = {0.f, 0.f}, d1 = {0.f, 0.f};
#pragma unroll
        for (int qb = 0; qb < 4; ++qb) {
            f32x4 a4[4];
            SCHED_FENCE();
#pragma unroll
            for (int j = 0; j < 4; ++j) a4[j] = *(const LAS f32x4*)(bs + 192 + (qb * 4 + j) * 4);
            SCHED_FENCE();
#pragma unroll
            for (int j = 0; j < 4; ++j) { const int q = qb * 4 + j; d0 = S2[2 * q] * __builtin_shufflevector(a4[j], a4[j], 0, 1) + d0; d1 = S2[2 * q + 1] * __builtin_shufflevector(a4[j], a4[j], 2, 3) + d1; }
        }
        const float sa = (d0[0] + d0[1]) + (d1[0] + d1[1]);
        const f32x2n sa2 = {sa, sa}, vv2 = {vv, vv};
        f32x2n y0 = {0.f, 0.f}, y1 = {0.f, 0.f};
#pragma unroll
        for (int qb = 0; qb < 4; ++qb) {
            f32x4 w4[4], k4[4], b4[4], r4[4];
            SCHED_FENCE();
#pragma unroll
            for (int j = 0; j < 4; ++j) { const int o = (qb * 4 + j) * 4; w4[j] = *(const LAS f32x4*)(bs + 64 + o); k4[j] = *(const LAS f32x4*)(bs + 128 + o); b4[j] = *(const LAS f32x4*)(bs + 256 + o); r4[j] = *(const LAS f32x4*)(bs + o); }
            SCHED_FENCE();
#pragma unroll
            for (int j = 0; j < 4; ++j) { const int q = qb * 4 + j;
                f32x2n tl = __builtin_shufflevector(k4[j], k4[j], 0, 1) * vv2, th = __builtin_shufflevector(k4[j], k4[j], 2, 3) * vv2;
                tl = __builtin_shufflevector(b4[j], b4[j], 0, 1) * sa2 + tl; th = __builtin_shufflevector(b4[j], b4[j], 2, 3) * sa2 + th;
                S2[2 * q] = S2[2 * q] * __builtin_shufflevector(w4[j], w4[j], 0, 1) + tl; S2[2 * q + 1] = S2[2 * q + 1] * __builtin_shufflevector(w4[j], w4[j], 2, 3) + th;
                y0 = S2[2 * q] * __builtin_shufflevector(r4[j], r4[j], 0, 1) + y0; y1 = S2[2 * q + 1] * __builtin_shufflevector(r4[j], r4[j], 2, 3) + y1; }
        }
        yraw[(row0 + t) * YRC + ch] = (y0[0] + y0[1]) + (y1[0] + y1[1]);
    }
    float* so = A.out + O_SRW + ((((size_t)l * 128 + b) * 12 + h) * 64 + lane) * 64;
#pragma unroll
    for (int q = 0; q < 16; ++q) *(f32x4*)(so + q * 4) = (f32x4){S2[2 * q][0], S2[2 * q][1], S2[2 * q + 1][0], S2[2 * q + 1][1]};
    __builtin_amdgcn_wave_barrier();
}

__device__ __forceinline__ void hgrn_wave_item(const Args& A, int l, LAS float* wl, int b, int h, int half, int lane) {
    const bf16* proj = (const bf16*)(A.ws + WS_PROJ);
    float* yraw = (float*)(A.ws + WS_YRAW);
    const size_t row0 = (size_t)NP + (size_t)b * 8;
    const int v = half * 64 + lane;
    float S[128];
    const float* sp = A.in[4] + (((size_t)l * 128 + b) * 6 + h) * 16384 + v;
    SCHED_FENCE();
#pragma unroll
    for (int k = 0; k < 128; ++k) S[k] = sp[(size_t)k * 128];
    unsigned vu[8];
#pragma unroll
    for (int t = 0; t < 8; ++t) vu[t] = proj[(row0 + t) * INC + HG_OFF + 1536 + h * 128 + v];
    SCHED_FENCE();
    float vv[8];
#pragma unroll
    for (int t = 0; t < 8; ++t) vv[t] = bfu(vu[t]);
#pragma unroll
    for (int ii = 0; ii < 2; ++ii) {
        const int c = h * 128 + lane + 64 * ii;
        const float lb = (l == 0) ? 0.f : sigm(A.in[21][768 + c] - A.in[21][c]);
        unsigned uq[8], uf[8];
        SCHED_FENCE();
#pragma unroll
        for (int t = 0; t < 8; ++t) { const bf16* p = proj + (row0 + t) * INC + HG_OFF + c; uq[t] = p[0]; uf[t] = p[768]; }
        SCHED_FENCE();
#pragma unroll
        for (int t = 0; t < 8; ++t) { const float pq = bfu(uq[t]), pf = bfu(uf[t]);
            wl[t * 256 + lane + 64 * ii] = pq * sigm(pq); wl[t * 256 + 128 + lane + 64 * ii] = lb + (1.f - lb) * sigm(pf); }
    }
    LDS_WAIT(); __builtin_amdgcn_wave_barrier();
#pragma unroll
    for (int t = 0; t < 8; ++t) {
        const LAS float* bs = wl + t * 256;
        const float x = vv[t];
        float o0 = 0.f, o1 = 0.f;
#pragma unroll
        for (int q = 0; q < 32; ++q) { const f32x4 q4 = *(const LAS f32x4*)(bs + q * 4), f4 = *(const LAS f32x4*)(bs + 128 + q * 4);
#pragma unroll
            for (int e = 0; e < 4; ++e) S[q * 4 + e] = x + f4[e] * (S[q * 4 + e] - x);
            o0 += S[q * 4] * q4[0] + S[q * 4 + 1] * q4[1]; o1 += S[q * 4 + 2] * q4[2] + S[q * 4 + 3] * q4[3]; }
        yraw[(row0 + t) * YRC + 768 + h * 128 + v] = o0 + o1;
    }
    float* so = A.out + O_SHG + (((size_t)l * 128 + b) * 6 + h) * 16384 + v;
#pragma unroll
    for (int k = 0; k < 128; ++k) so[(size_t)k * 128] = S[k];
    __builtin_amdgcn_wave_barrier();
}

__device__ __forceinline__ void lru_wave_item(const Args& A, int l, int b, int cgp, int lane) {
    const int c = cgp * 64 + lane;
    const size_t row0 = (size_t)NP + (size_t)b * 8;
    const bf16* proj = (const bf16*)(A.ws + WS_PROJ); const bf16* xcb = (const bf16*)(A.ws + WS_XCB);
    const bf16* Lr = (const bf16*)(A.ws + WS_LR);
    bf16* ymix = (bf16*)(A.ws + WS_YMIX);
    const float ba = A.in[26][l * 512 + c], bx = A.in[28][l * 512 + c], sp = log1pf(__expf(-A.in[29][l * 512 + c]));
    float hc = A.in[5][((size_t)l * 128 + b) * 512 + c];
    unsigned gr[8], gi[8], xc[8], gt[8];
    SCHED_FENCE();
#pragma unroll
    for (int e = 0; e < 8; ++e) { const size_t m = row0 + e; gr[e] = Lr[m * LRCOLS + c]; gi[e] = Lr[m * LRCOLS + 512 + c]; xc[e] = xcb[m * 512 + c]; gt[e] = proj[m * INC + LR_OFF + 512 + c]; }
    SCHED_FENCE();
#pragma unroll
    for (int e = 0; e < 8; ++e) { float a, u; LRU_AU(bfu(gr[e]), bfu(gi[e]), bfu(xc[e]), a, u); hc = a * hc + u; ymix[(row0 + e) * DM + 1536 + c] = f2bf(hc * gelu_tanh(bfu(gt[e]))); }
    A.out[O_SLR + ((size_t)l * 128 + b) * 512 + c] = hc;
}

constexpr int N_BLOCK_ITEMS = 248, N_DYN_BLOCK_ITEMS = 768, N_WAVE_ITEMS = 1536 + 1024;
__device__ __forceinline__ void phase_b2(const Args& A, int l, LAS unsigned char* lds, int G, int ctr_idx) {
    const int tid = tidx(), lane = tid & 63, wave = __builtin_amdgcn_readfirstlane(tid >> 6);
    for (int bi = blockIdx.x; bi < N_BLOCK_ITEMS; bi += G) {
        if (bi < 192) rwkv_block_item(A, l, (LAS float*)lds, (bi & 7) + 8 * (bi >> 5), (bi >> 3) & 3);
        else if (bi < 224) lru_block_item(A, l, (LAS float*)lds, (bi - 192) >> 3, (bi - 192) & 7);
        else hgrn_mfma_item(A, l, lds, false, (bi - 224) / 6, (bi - 224) % 6);
        __syncthreads();
    }
    unsigned* ctr = (unsigned*)(A.ws + WS_CTL) + 64 * ctr_idx;
    volatile LAS int* slot = (volatile LAS int*)(lds + 131072 + 320 + 64);
    LAS float* wl = (LAS float*)(lds + wave * 12288);
    for (;;) {
        int it = 0;
        if (lane == 0) it = (int)atomicAdd(ctr, 1u);
        it = __builtin_amdgcn_readfirstlane(it);
        if (it >= N_WAVE_ITEMS) break;
        if (it < 1536) rwkv_wave_item(A, l, wl, it / 12, it % 12, lane);
        else { const int r = it - 1536; lru_wave_item(A, l, r >> 3, r & 7, lane); }
    }
    for (;;) {
        __syncthreads();
        if (tid == 0) *slot = (int)atomicAdd(ctr + 16, 1u);
        __syncthreads();
        const int it = *slot;
        if (it >= N_DYN_BLOCK_ITEMS) break;
        hgrn_mfma_item(A, l, lds, true, it / 6, it % 6);
    }
}

__device__ __forceinline__ void phase_b3(const Args& A, int l, int gw, int NGW, int lane) {
    const bf16* proj = (const bf16*)(A.ws + WS_PROJ);
    const bf16* L = (const bf16*)(A.ws + WS_L);
    const float* yraw = (const float*)(A.ws + WS_YRAW);
    const unsigned char* rwin = A.ws + WS_RWIN;
    bf16* ymix = (bf16*)(A.ws + WS_YMIX);
    for (int idx = gw; idx < MR * 5; idx += NGW) {
        const int m = idx / 5, u = idx % 5;
        if (u < 3) {
            ROW_INFO(m)
            float P_mur[4], P_muk[4], P_muv[4], P_a0[4], P_ka[4], P_rk[4], P_lw[4], P_lb[4];
            float y[4], pr[4], pk[4], pv[4], qr[4], qk[4], qv[4]; unsigned la[4], g[4], ur[4], uk[4], uv[4], vr[4], vk[4], vv[4];
            SCHED_FENCE();
#pragma unroll
            for (int i = 0; i < 4; ++i) {
                const int ch = (u * 4 + i) * 64 + lane;
                y[i] = yraw[(size_t)m * YRC + ch];
                if (!samp) {
                    const unsigned char* o = rwin + ((size_t)((m >> 11) * 12 + (u * 4 + i)) * 2048 + (m & 2047)) * 896 + lane * 2;
                    ur[i] = *(const bf16*)(o + 256); uk[i] = *(const bf16*)(o + 384); uv[i] = *(const bf16*)(o + 768);
                    vr[i] = 0; vk[i] = 0; vv[i] = 0; qr[i] = 0.f; qk[i] = 0.f; qv[i] = 0.f; la[i] = 0;
                    P_mur[i] = 0.f; P_muk[i] = 0.f; P_muv[i] = 0.f; P_a0[i] = 0.f; P_ka[i] = 0.f;
                } else {
                    const bf16* p = proj + (size_t)m * INC + ch;
                    ur[i] = p[0]; uk[i] = p[768]; uv[i] = p[1536];
                    if (rt > 0) { vr[i] = *(p - INC); vk[i] = *(p - INC + 768); vv[i] = *(p - INC + 1536); qr[i] = 0.f; qk[i] = 0.f; qv[i] = 0.f; }
                    else { const float* sh = A.in[3] + ((size_t)l * 128 + rb) * 2560; qr[i] = sh[ch]; qk[i] = sh[768 + ch]; qv[i] = sh[1536 + ch]; vr[i] = 0; vk[i] = 0; vv[i] = 0; }
                    la[i] = L[(size_t)m * LCOLS + 768 + ch];
                    P_mur[i] = A.in[10][l * 2560 + ch]; P_muk[i] = A.in[10][l * 2560 + 768 + ch]; P_muv[i] = A.in[10][l * 2560 + 1536 + ch];
                    P_a0[i] = A.in[13][l * 768 + ch]; P_ka[i] = A.in[17][l * 768 + ch];
                }
                g[i] = L[(size_t)m * LCOLS + 1536 + ch];
                P_rk[i] = A.in[18][l * 768 + ch]; P_lw[i] = A.in[19][l * 768 + ch]; P_lb[i] = A.in[20][l * 768 + ch];
            }
            SCHED_FENCE();
#pragma unroll
            for (int i = 0; i < 4; ++i) { pr[i] = bfu(ur[i]); pk[i] = bfu(uk[i]); pv[i] = bfu(uv[i]); if (rt > 0) { qr[i] = bfu(vr[i]); qk[i] = bfu(vk[i]); qv[i] = bfu(vv[i]); } }
#pragma unroll
            for (int i = 0; i < 4; ++i) {
                const int ch = (u * 4 + i) * 64 + lane;
                const float mean = wave_sum_fast(y[i]) * (1.f / 64.f); const float d = y[i] - mean; const float var = wave_sum_fast(d * d) * (1.f / 64.f);
                const float yn = d * rsqrtf(var + 64e-5f) * P_lw[i] + P_lb[i];
                const float xr = pr[i] + (qr[i] - pr[i]) * P_mur[i], xk = pk[i] + (qk[i] - pk[i]) * P_muk[i], xv = pv[i] + (qv[i] - pv[i]) * P_muv[i];
                const float a = sigm(P_a0[i] + bfu(la[i]));
                const float kf = xk * (1.f + (a - 1.f) * P_ka[i]);
                const float bsum = wave_sum_fast(xr * kf * P_rk[i]);
                ymix[(size_t)m * DM + ch] = f2bf((yn + bsum * xv) * bfu(g[i]));
            }
        } else {
            float o0[3], o1[3], g0[3], g1[3], n0[3], n1[3]; unsigned h0[3], h1[3];
            SCHED_FENCE();
#pragma unroll
            for (int i = 0; i < 3; ++i) {
                const int c0 = ((u - 3) * 3 + i) * 128 + lane, c1 = c0 + 64;
                o0[i] = yraw[(size_t)m * YRC + 768 + c0]; o1[i] = yraw[(size_t)m * YRC + 768 + c1];
                h0[i] = proj[(size_t)m * INC + HG_OFF + 2304 + c0]; h1[i] = proj[(size_t)m * INC + HG_OFF + 2304 + c1];
                n0[i] = A.in[22][l * 768 + c0]; n1[i] = A.in[22][l * 768 + c1];
            }
            SCHED_FENCE();
#pragma unroll
            for (int i = 0; i < 3; ++i) { g0[i] = bfu(h0[i]); g1[i] = bfu(h1[i]); }
#pragma unroll
            for (int i = 0; i < 3; ++i) {
                const int c0 = ((u - 3) * 3 + i) * 128 + lane, c1 = c0 + 64;
                const float rs = rsqrtf(wave_sum_fast(o0[i] * o0[i] + o1[i] * o1[i]) * (1.f / 128.f) + 1e-6f);
                ymix[(size_t)m * DM + 768 + c0] = f2bf(o0[i] * rs * n0[i] * (g0[i] * sigm(g0[i])));
                ymix[(size_t)m * DM + 768 + c1] = f2bf(o1[i] * rs * n1[i] * (g1[i] * sigm(g1[i])));
            }
        }
    }
}

__device__ __forceinline__ void unpack8(const u32x4 u, float (&x)[8]) { x[0] = bflo(u.x); x[1] = bfhi(u.x); x[2] = bflo(u.y); x[3] = bfhi(u.y); x[4] = bflo(u.z); x[5] = bfhi(u.z); x[6] = bflo(u.w); x[7] = bfhi(u.w); }
__device__ __forceinline__ void phase_d2(const Args& A, int l, int gt, int NGT) {
    const bf16* GV = (const bf16*)(A.ws + WS_GV);
    bf16* H = (bf16*)(A.ws + WS_H);
    for (int it = gt; it < (MR / 8) * 704; it += NGT) {
        const int chunk = it / 704, c = (it % 704) * 8;
        const int m0 = chunk * 8;
        const bool samp = m0 >= NP;
        float cw0[8], cw1[8], cw2[8], cb[8];
        {
            const float* cwp = A.in[33] + (size_t)l * 3 * FF + c; const float* cbp = A.in[34] + (size_t)l * FF + c;
#pragma unroll
            for (int h = 0; h < 2; ++h) { const f32x4 a = *(const f32x4*)(cwp + 4 * h), b = *(const f32x4*)(cwp + FF + 4 * h), d = *(const f32x4*)(cwp + 2 * FF + 4 * h), e = *(const f32x4*)(cbp + 4 * h);
#pragma unroll
                for (int q = 0; q < 4; ++q) { cw0[4 * h + q] = a[q]; cw1[4 * h + q] = b[q]; cw2[4 * h + q] = d[q]; cb[4 * h + q] = e[q]; } }
        }
        float x1[8], x2[8];
        if (!samp) {
            const int t0 = m0 & 2047;
            if (t0 > 0) { unpack8(*(const u32x4*)(GV + (size_t)(m0 - 1) * FF2 + c), x1); unpack8(*(const u32x4*)(GV + (size_t)(m0 - 2) * FF2 + c), x2); }
            else {
#pragma unroll
                for (int e = 0; e < 8; ++e) { x1[e] = 0.f; x2[e] = 0.f; } }
        }
        for (int r4 = 0; r4 < 2; ++r4) {
          u32x4 rawg[4], rawv[4];
          SCHED_FENCE();
#pragma unroll
          for (int q = 0; q < 4; ++q) { const bf16* gp = GV + (size_t)(m0 + r4 * 4 + q) * FF2 + c; rawg[q] = *(const u32x4*)gp; rawv[q] = *(const u32x4*)(gp + FF); }
          SCHED_FENCE();
#pragma unroll
          for (int q = 0; q < 4; ++q) {
            const int r = r4 * 4 + q;
            const int m = m0 + r;
            if (samp && (r & 7) == 0) {
                const int rb = (m - NP) >> 3;
                const float* s = A.in[7] + (((size_t)l * 128 + rb) * 2) * FF + c;
#pragma unroll
                for (int h = 0; h < 2; ++h) { const f32x4 a = *(const f32x4*)(s + 4 * h), b = *(const f32x4*)(s + FF + 4 * h);
#pragma unroll
                    for (int q = 0; q < 4; ++q) { x2[4 * h + q] = a[q]; x1[4 * h + q] = b[q]; } }
            }
            float x0[8], vl[8], o[8];
            unpack8(rawg[q], x0); unpack8(rawv[q], vl);
#pragma unroll
            for (int e = 0; e < 8; ++e) { const float gc = cb[e] + cw0[e] * x2[e] + cw1[e] * x1[e] + cw2[e] * x0[e]; o[e] = gc * sigm(gc) * vl[e]; }
            u32x4 w; w.x = pk2(o[0], o[1]); w.y = pk2(o[2], o[3]); w.z = pk2(o[4], o[5]); w.w = pk2(o[6], o[7]);
            *(u32x4*)(H + (size_t)m * FF + c) = w;
            const int rt = samp ? (r & 7) : (m & 2047), rT = samp ? 8 : 2048;
            if (rt >= rT - 2) {
                const int rb = samp ? (m - NP) >> 3 : m >> 11;
                float* dst = A.out + (samp ? O_SFC + (((size_t)l * 128 + rb) * 2 + (rt - (rT - 2))) * FF : O_PFC + (((size_t)l * 4 + rb) * 2 + (rt - (rT - 2))) * FF) + c;
                *(f32x4*)dst = (f32x4){x0[0], x0[1], x0[2], x0[3]}; *(f32x4*)(dst + 4) = (f32x4){x0[4], x0[5], x0[6], x0[7]};
            }
#pragma unroll
            for (int e = 0; e < 8; ++e) { x2[e] = x1[e]; x1[e] = x0[e]; }
          }
        }
    }
}

__device__ __forceinline__ void phase_final(const Args& A, int gw, int NGW, int lane) {
    float* Y = A.out + O_Y; const bf16* Xb = (const bf16*)(A.ws + WS_XB); const float* ss = (const float*)(A.ws + WS_SS) + 4 * MR;
    for (int m = gw; m < MR; m += NGW) {
        u32x2 xv[8]; f32x4 nf[8];
        SCHED_FENCE();
        const float ssm = ss[m];
#pragma unroll
        for (int i = 0; i < 8; ++i) { xv[i] = *(const u32x2*)(Xb + (size_t)m * DM + i * 256 + lane * 4); nf[i] = *(const f32x4*)(A.in[36] + i * 256 + lane * 4); }
        SCHED_FENCE();
        const float rs = rsqrtf(ssm * (1.f / 2048.f) + 1e-6f);
#pragma unroll
        for (int i = 0; i < 8; ++i) *(f32x4*)(Y + (size_t)m * DM + i * 256 + lane * 4) = (f32x4){bflo(xv[i].x), bfhi(xv[i].x), bflo(xv[i].y), bfhi(xv[i].y)} * rs * nf[i];
    }
}

#ifndef REP_GEMM
#define REP_GEMM 1
#endif
#ifndef REP_B2
#define REP_B2 1
#endif
#ifndef REP_EW
#define REP_EW 1
#endif
__global__ void __launch_bounds__(512, 2) mk_fwd(Args A) {
    extern __shared__ __attribute__((aligned(16))) unsigned char lds_raw[];
    LAS unsigned char* lds = (LAS unsigned char*)lds_raw;
    cg::grid_group grid = cg::this_grid();
    volatile LAS unsigned* MISC = (volatile LAS unsigned*)(lds + 131072 + 320);
    if (threadIdx.x < 32) MISC[threadIdx.x] = 0u;
    __syncthreads();
    XcdBarrier xbar = xcd_barrier_post((unsigned*)(A.ws + WS_XBAR), MISC + 8);
#define GSYNC() xcd_barrier(xbar)
#define IDLE_CONVERT(first256, lay, lo, hi) do { const int tid_ = tidx(), lane_ = tid_ & 63, wave_ = __builtin_amdgcn_readfirstlane(tid_ >> 6); const int first_ = (G == 256) ? (first256) : 0; \
        if (bx >= first_) convert_weights(A, lds, (bx - first_) * 8 + wave_, (G - first_) * 8, wave_, lane_, (lay), 1, (lo), (hi)); } while (0)
    const int G = gridDim.x, bx = blockIdx.x, NGW = G * 8, NGT = G * 512;
#define TID_VARS const int tid = tidx(), lane = tid & 63, wave = __builtin_amdgcn_readfirstlane(tid >> 6), gw = bx * 8 + wave, gt = bx * 512 + tid; (void)lane; (void)gw; (void)gt;
    float* const ss = (float*)(A.ws + WS_SS);
    bf16* const Xb = (bf16*)(A.ws + WS_XB);

    { TID_VARS phase_prologue(A, lds, gw, NGW, gt, NGT, wave, lane); }
    grid.sync();
    for (int l = 0; l < 2; ++l) {
        for (int rep = 0; rep < REP_GEMM; ++rep) {
            pg8::Gemm g{(const pg8::bf16_t*)(A.ws + WS_XB), (const pg8::bf16_t*)(A.ws + WS_WIN) + (size_t)l * INC * DM, MR, INC, DM};
            pg8::StaticOrder S; S.init(MR, INC, G, bx);
            EpiScaleBf16 E{(bf16*)(A.ws + WS_PROJ), INC, ss + (2 * l) * MR};
            pg8::gemm_phase<EpiScaleBf16, pg8::StaticOrder, true, true>(lds, g, S, E);
            if (l == 0 && rep == 0) IDLE_CONVERT(168, 0, 19968, 1 << 30);
            GSYNC();
        }
        for (int rep = 0; rep < REP_EW; ++rep) { TID_VARS phase_b1a(A, l, gw, NGW, lane); GSYNC(); }
        for (int rep = 0; rep < REP_GEMM; ++rep) {
            pg8::Gemm g{(const pg8::bf16_t*)(A.ws + WS_AP), (const pg8::bf16_t*)(A.ws + WS_BL) + (size_t)l * LCOLS * 256, MR, LCOLS, 256};
            pg8::StaticOrder S; S.init(MR, LCOLS, G, bx);
            EpiBf16 E{(bf16*)(A.ws + WS_L), LCOLS};
            pg8::gemm_phase<EpiBf16, pg8::StaticOrder, true, true>(lds, g, S, E);
            pg8::Gemm g2{(const pg8::bf16_t*)(A.ws + WS_XCB), (const pg8::bf16_t*)(A.ws + WS_BLRU) + (size_t)l * LRCOLS * 512, MR, LRCOLS, 512};
            pg8::StaticOrder S2; S2.init(MR, LRCOLS, G, G - 1 - bx);
            EpiBf16 E2{(bf16*)(A.ws + WS_LR), LRCOLS};
            pg8::gemm_phase<EpiBf16, pg8::StaticOrder, true, true>(lds, g2, S2, E2);
            GSYNC();
        }
        { TID_VARS phase_b1c(A, l, gw, NGW, lane); } hgrn_image_items(A, l, lds, G); GSYNC();
        for (int rep = 0; rep < REP_B2; ++rep) { phase_b2(A, l, lds, G, 1 + l + 2 * rep); GSYNC(); }
        for (int rep = 0; rep < REP_EW; ++rep) { TID_VARS phase_b3(A, l, gw, NGW, lane); GSYNC(); }
        {
            pg8::Gemm g{(const pg8::bf16_t*)(A.ws + WS_YMIX), (const pg8::bf16_t*)(A.ws + WS_WOUT) + (size_t)l * DM * DM, MR, DM, DM};
            pg8::StaticOrder S; S.init(MR, DM, G, bx);
            EpiResid E{Xb, ss + (2 * l + 1) * MR};
            pg8::gemm_phase<EpiResid, pg8::StaticOrder, true, true>(lds, g, S, E);
        }
        if (l == 0) IDLE_CONVERT(32, 0, 8704, 19968);
        GSYNC();
        for (int rep = 0; rep < REP_GEMM; ++rep) {
            pg8::Gemm g{(const pg8::bf16_t*)(A.ws + WS_XB), (const pg8::bf16_t*)(A.ws + WS_WUP) + (size_t)l * FF2 * DM, MR, FF2, DM};
            pg8::StaticOrder S; S.init(MR, FF2, G, bx);
            EpiScaleBf16 E{(bf16*)(A.ws + WS_GV), FF2, ss + (2 * l + 1) * MR};
            pg8::gemm_phase<EpiScaleBf16, pg8::StaticOrder, true, true>(lds, g, S, E);
            if (l == 0 && rep == 0) IDLE_CONVERT(48, 1, 0, 8704);
            GSYNC();
        }
        for (int rep = 0; rep < REP_EW; ++rep) { TID_VARS phase_d2(A, l, gt, NGT); GSYNC(); }
        {
            pg8::Gemm g{(const pg8::bf16_t*)(A.ws + WS_H), (const pg8::bf16_t*)(A.ws + WS_WDN) + (size_t)l * DM * FF, MR, DM, FF};
            pg8::StaticOrder S; S.init(MR, DM, G, bx);
            EpiResid E{Xb, ss + (2 * l + 2) * MR};
            pg8::gemm_phase<EpiResid, pg8::StaticOrder, true, true>(lds, g, S, E);
        }
        if (l == 0) {
            const int tid = tidx(), lane = tid & 63, wave = __builtin_amdgcn_readfirstlane(tid >> 6);
            const int first = (G == 256) ? 32 : 0;
            if (bx >= first) convert_weights(A, lds, (bx - first) * 8 + wave, (G - first) * 8, wave, lane, 1, 1, 8704, 1 << 30);
        }
        GSYNC();
    }
    { TID_VARS phase_final(A, gw, NGW, lane); }
}

extern "C" void kernel_launch(void* const* d_in, const int* in_sizes, int n_in, void* d_out, int out_size, void* d_ws, size_t ws_size, hipStream_t stream) {
    static int grid = 0;
    if (grid == 0) {
        if (n_in != 37 || (size_t)out_size != O_END || ws_size < WS_END) { fprintf(stderr, "kernel_launch: unexpected shapes: n_in %d out %d ws %zu (need %zu)\n", n_in, out_size, ws_size, (size_t)WS_END); grid = -1; return; }
        int dev = 0, cus = 0, per_cu = 0;
        if (hipGetDevice(&dev) != hipSuccess || hipDeviceGetAttribute(&cus, hipDeviceAttributeMultiprocessorCount, dev) != hipSuccess) { grid = -1; return; }
        if (hipFuncSetAttribute((const void*)mk_fwd, hipFuncAttributeMaxDynamicSharedMemorySize, LDS_BYTES) != hipSuccess) { fprintf(stderr, "kernel_launch: hipFuncSetAttribute failed\n"); grid = -1; return; }
        if (hipOccupancyMaxActiveBlocksPerMultiprocessor(&per_cu, (const void*)mk_fwd, 512, LDS_BYTES) != hipSuccess || per_cu < 1) { fprintf(stderr, "kernel_launch: occupancy query failed (%d)\n", per_cu); (void)hipGetLastError(); grid = -1; return; }
        grid = cus;
    }
    if (grid < 0) return;
    (void)hipMemsetAsync((char*)d_ws + WS_CTL, 0, CTL_ZERO_BYTES, stream);
    Args a{};
    for (int i = 0; i < 37; ++i) a.in[i] = (const float*)d_in[i];
    a.out = (float*)d_out; a.ws = (unsigned char*)d_ws;
    void* args[] = {&a};
    hipError_t e = hipLaunchCooperativeKernel((const void*)mk_fwd, dim3(grid), dim3(512), args, LDS_BYTES, stream);
    if (e != hipSuccess) fprintf(stderr, "kernel_launch: cooperative launch failed: %s (grid %d)\n", hipGetErrorString(e), grid);
}
```
